# Optimizing an MI355X kernel written in HIP

```python
import jax, jax.numpy as jnp
from jax import lax
import numpy as np

D_MODEL = 1024
BATCH = 8
SEQ = 2048
DEPTH = 2
DEC_BATCH = 128
DEC_SEQ = 8
PAST_LEN = 16384
PAGE_SIZE = 128

N_MIXERS = 2
POOL_WINDOWS = (2, 4, 8, 16)
N_POOL_GROUPS = len(POOL_WINDOWS)
POOL_GROUP = D_MODEL // N_POOL_GROUPS
POOL_BUF = max(POOL_WINDOWS) - 1
CHUNK = 128
D_SGU = D_MODEL
N_SGU_GROUPS = 4
SGU_GROUP = D_SGU // N_SGU_GROUPS
D_FF = 4 * D_MODEL
EPS = 1e-6
N_POOL_LAYERS = (DEPTH + 1) // 2
N_SGU_LAYERS = DEPTH // 2

kernel_name = "pool_sgu_hybrid_decode_step"


def rms_norm(x, g):
    xf = x.astype(jnp.float32)
    y = xf * lax.rsqrt(jnp.mean(xf * xf, axis=-1, keepdims=True) + EPS)
    return (y * g.astype(jnp.float32)).astype(x.dtype)


def layer_norm(x, g, b):
    xf = x.astype(jnp.float32)
    mu = jnp.mean(xf, axis=-1, keepdims=True)
    xc = xf - mu
    var = jnp.mean(xc * xc, axis=-1, keepdims=True)
    return (xc * lax.rsqrt(var + EPS) * g.astype(jnp.float32) + b.astype(jnp.float32)).astype(x.dtype)


def ada_modulation(c, w_ada, b_ada):
    m = jax.nn.silu(c) @ w_ada + b_ada
    return jnp.split(m[:, None, :], 6, axis=-1)


def modulate(x, g, shift, scale):
    return rms_norm(x, g) * (1 + scale) + shift


def pool_mixer(h, buf, pos0, w_pool, pool_scale):
    B, L, D = h.shape
    xx = jnp.concatenate([buf.astype(h.dtype), h], axis=1)
    cs = jnp.cumsum(xx.astype(jnp.float32), axis=1)
    cs = jnp.pad(cs, ((0, 0), (1, 0), (0, 0)))
    pos = pos0 + jnp.arange(L)
    hi = cs[:, POOL_BUF + 1:POOL_BUF + 1 + L]
    means = []
    for gi, w in enumerate(POOL_WINDOWS):
        sl = slice(gi * POOL_GROUP, (gi + 1) * POOL_GROUP)
        lo = cs[:, POOL_BUF + 1 - w:POOL_BUF + 1 - w + L, sl]
        cnt = jnp.minimum(w, pos + 1).astype(jnp.float32)[None, :, None]
        means.append((hi[:, :, sl] - lo) / cnt)
    mean = jnp.concatenate(means, axis=-1)
    d = (mean - h.astype(jnp.float32)).astype(h.dtype)
    d = d.reshape(B, L, N_POOL_GROUPS, POOL_GROUP)
    y = jnp.einsum('blgc,gcd->blgd', d, w_pool).reshape(B, L, D)
    return y * pool_scale, xx[:, -POOL_BUF:]


def sgu_mixer(h, w_in, b_in, ln_g, ln_b, w_sp, b_sp, w_out):
    B, L, _ = h.shape
    z = jax.nn.gelu(h @ w_in + b_in, approximate=False)
    u, v = jnp.split(z, 2, axis=-1)
    v = layer_norm(v, ln_g, ln_b)
    n_chunks = -(-L // CHUNK)
    pad = n_chunks * CHUNK - L
    vc = jnp.pad(v, ((0, 0), (0, pad), (0, 0))).reshape(B, n_chunks, CHUNK, N_SGU_GROUPS, SGU_GROUP)
    mask = jnp.tril(jnp.ones((CHUNK, CHUNK), dtype=bool))
    w_eff = jnp.where(mask[None], w_sp, 0).astype(vc.dtype)
    mixed = jnp.einsum('gts,bnsgc->bntgc', w_eff, vc) + b_sp.T[None, None, :, :, None]
    mixed = mixed.reshape(B, n_chunks * CHUNK, D_SGU)[:, :L]
    y = (u * mixed) @ w_out
    last_start = ((L - 1) // CHUNK) * CHUNK
    return y, v[:, last_start:]


def channel_mlp(h, w1, w2):
    a = jax.nn.relu(h @ w1)
    return (a * a) @ w2


def trunk(x, c, pool_buf, pos0, norm_g, w_ada, b_ada, w_pool, pool_scale,
          sgu_w_in, sgu_b_in, sgu_ln_g, sgu_ln_b, sgu_w_sp, sgu_b_sp, sgu_w_out,
          mlp_w1, mlp_w2, final_g):
    new_pool, new_v = [], []
    for i in range(DEPTH):
        sh1, sc1, g1, sh2, sc2, g2 = ada_modulation(c, w_ada[i], b_ada[i])
        h = modulate(x, norm_g[i, 0], sh1, sc1)
        j = i // N_MIXERS
        if i % N_MIXERS == 0:
            buf = pool_buf[j] if pool_buf is not None else jnp.zeros((x.shape[0], POOL_BUF, x.shape[2]), x.dtype)
            y, nb = pool_mixer(h, buf, pos0, w_pool[j], pool_scale[j])
            new_pool.append(nb)
        else:
            y, vr = sgu_mixer(h, sgu_w_in[j], sgu_b_in[j], sgu_ln_g[j], sgu_ln_b[j],
                              sgu_w_sp[j], sgu_b_sp[j], sgu_w_out[j])
            new_v.append(vr)
        x = x + g1 * y
        h = modulate(x, norm_g[i, 1], sh2, sc2)
        x = x + g2 * channel_mlp(h, mlp_w1[i], mlp_w2[i])
    return rms_norm(x, final_g), jnp.stack(new_pool), jnp.stack(new_v)


def setup_inputs(seed: int = 0) -> dict:
    key = jax.random.key(seed)
    ks = jax.random.split(key, 24)
    f32 = jnp.float32
    nrm = lambda k, s, scale: jax.random.normal(k, s, f32) * scale
    return {
        "x_prompt": nrm(ks[0], (BATCH, SEQ, D_MODEL), 1.0),
        "x_sample": nrm(ks[1], (DEC_BATCH, DEC_SEQ, D_MODEL), 1.0),
        "c_prompt": nrm(ks[2], (BATCH, D_MODEL), 1.0),
        "c_sample": nrm(ks[3], (DEC_BATCH, D_MODEL), 1.0),
        "state_pool": nrm(ks[4], (N_POOL_LAYERS, DEC_BATCH, POOL_BUF, D_MODEL), 1.0),
        "norm_g": 1.0 + nrm(ks[5], (DEPTH, 2, D_MODEL), 0.05),
        "w_ada": nrm(ks[6], (DEPTH, D_MODEL, 6 * D_MODEL), 0.5 * D_MODEL ** -0.5),
        "b_ada": nrm(ks[7], (DEPTH, 6 * D_MODEL), 0.01),
        "w_pool": nrm(ks[8], (N_POOL_LAYERS, N_POOL_GROUPS, POOL_GROUP, POOL_GROUP), POOL_GROUP ** -0.5),
        "pool_scale": 1.0 + nrm(ks[9], (N_POOL_LAYERS, D_MODEL), 0.05),
        "sgu_w_in": nrm(ks[10], (N_SGU_LAYERS, D_MODEL, 2 * D_SGU), D_MODEL ** -0.5),
        "sgu_b_in": nrm(ks[11], (N_SGU_LAYERS, 2 * D_SGU), 0.01),
        "sgu_ln_g": 1.0 + nrm(ks[12], (N_SGU_LAYERS, D_SGU), 0.05),
        "sgu_ln_b": nrm(ks[13], (N_SGU_LAYERS, D_SGU), 0.01),
        "sgu_w_sp": nrm(ks[14], (N_SGU_LAYERS, N_SGU_GROUPS, CHUNK, CHUNK), CHUNK ** -0.5),
        "sgu_b_sp": 1.0 + nrm(ks[15], (N_SGU_LAYERS, N_SGU_GROUPS, CHUNK), 0.05),
        "sgu_w_out": nrm(ks[16], (N_SGU_LAYERS, D_SGU, D_MODEL), D_SGU ** -0.5),
        "mlp_w1": nrm(ks[17], (DEPTH, D_MODEL, D_FF), D_MODEL ** -0.5),
        "mlp_w2": nrm(ks[18], (DEPTH, D_FF, D_MODEL), D_FF ** -0.5),
        "final_g": 1.0 + nrm(ks[19], (D_MODEL,), 0.05),
    }


def reference(x_prompt, x_sample, c_prompt, c_sample, state_pool, norm_g, w_ada, b_ada,
              w_pool, pool_scale, sgu_w_in, sgu_b_in, sgu_ln_g, sgu_ln_b, sgu_w_sp,
              sgu_b_sp, sgu_w_out, mlp_w1, mlp_w2, final_g):
    y_prompt, new_pool_prompt, new_sgu_v_prompt = trunk(
        x_prompt, c_prompt, None, 0, norm_g, w_ada, b_ada, w_pool, pool_scale,
        sgu_w_in, sgu_b_in, sgu_ln_g, sgu_ln_b, sgu_w_sp, sgu_b_sp, sgu_w_out,
        mlp_w1, mlp_w2, final_g)
    y_sample, new_pool_sample, new_sgu_v_sample = trunk(
        x_sample, c_sample, state_pool, PAST_LEN, norm_g, w_ada, b_ada, w_pool, pool_scale,
        sgu_w_in, sgu_b_in, sgu_ln_g, sgu_ln_b, sgu_w_sp, sgu_b_sp, sgu_w_out,
        mlp_w1, mlp_w2, final_g)
    return (y_prompt, y_sample, new_pool_prompt, new_pool_sample, new_sgu_v_prompt, new_sgu_v_sample)
```

```cpp
#include <hip/hip_runtime.h>
#include <cstdio>
#include <cstdint>

#ifndef MK_N_LAUNCHES
#define MK_N_LAUNCHES 1
#endif

__device__ __forceinline__ int opaque_tid() { int t = threadIdx.x; asm volatile("" : "+v"(t)); return t; }

namespace pg8 {
#define PG8_LAS __attribute__((address_space(3)))
typedef unsigned short bf16_t;
typedef short bf16x8 __attribute__((ext_vector_type(8)));
typedef float f32x4 __attribute__((ext_vector_type(4)));
typedef unsigned u32x4 __attribute__((ext_vector_type(4)));
typedef unsigned u32x2 __attribute__((ext_vector_type(2)));
constexpr int BM = 256, BK = 64, HALF = 128, HTB = HALF * BK * 2  , STAGE_BYTES = 8 * HTB, NXCD = 8, WGM = 8;

__host__ __device__ __forceinline__ int lds_byte(int r, int c) { const int st = (r >> 4) * 2 + (c >> 5), rr = r & 15, cc = c & 31, ob = rr * 64 + cc * 2; return st * 1024 + (ob ^ (((ob >> 9) & 1) << 5)); }
__host__ __device__ __forceinline__ void stage_rc(int b, int& R, int& C) { const int st = b / 1024, sb = b % 1024, swz = sb ^ (((sb >> 9) & 1) << 5); R = (st >> 1) * 16 + swz / 64; C = (st & 1) * 32 + (swz % 64) / 2; }
__host__ __device__ __forceinline__ int perm32(int rho) { const int n = rho >> 4, i = rho & 15; return 8 * (i >> 2) + 4 * n + (i & 3); }

struct Unit { int pm, pn; };
struct Gemm { const bf16_t* A; const bf16_t* Bt; int K, lda, ldb, a_pn_off; };

struct StaticOrder {
    int nM, nN, nwg, G, c;
    __host__ __device__ void init(int M, int N, int G_, int c_) { nM = M / BM; nN = N / BM; nwg = nM * nN; G = G_; c = c_; }
    __host__ __device__ bool next(int i, Unit& u) const {
        const long L = (long)i * G + c; if (L >= nwg) return false;
        int wgid = (int)L; { const int q = nwg / NXCD, r = nwg % NXCD, xcd = wgid % NXCD, off = wgid / NXCD; wgid = (xcd < r ? xcd * (q + 1) : r * (q + 1) + (xcd - r) * q) + off; }
        const int nig = WGM * nN, gid = wgid / nig, fm = gid * WGM, gsz = (nM - fm) < WGM ? (nM - fm) : WGM;
        u.pm = fm + ((wgid % nig) % gsz); u.pn = (wgid % nig) / gsz; return true;
    }
    __device__ __forceinline__ void a_ready(const Unit&) const {}
    __device__ __forceinline__ void done(const Unit&) const {}
};

__device__ __forceinline__ unsigned cvt_pk_bf16(float lo, float hi) { unsigned r; asm volatile("v_cvt_pk_bf16_f32 %0, %1, %2" : "=v"(r) : "v"(lo), "v"(hi)); return r; }
typedef float f32x2 __attribute__((ext_vector_type(2)));
__device__ __forceinline__ f32x2 gelu_pk(f32x2 v) {
    const f32x2 av = __builtin_elementwise_abs(v), d = av * 0.2316418882f + 1.0f;
    f32x2 t; t.x = __builtin_amdgcn_rcpf(d.x); t.y = __builtin_amdgcn_rcpf(d.y);
    f32x2 q = t * 0.5307027145f + (-0.7265760135f); q = q * t + 0.7107068705f; q = q * t + (-0.142248368f); q = q * t + 0.127414796f; q = q * t;
    const f32x2 s = (v * v) * (-0.72134752044f);
    f32x2 e; e.x = __builtin_amdgcn_exp2f(s.x); e.y = __builtin_amdgcn_exp2f(s.y);
    const f32x2 m = v * (q * e), r = v - m;
    f32x2 o; o.x = v.x < 0.f ? m.x : r.x; o.y = v.y < 0.f ? m.y : r.y; return o;
}

template <class Epi, class Sched, bool ALIGN_EPI = false, bool SP2 = false>
__device__ __forceinline__ void gemm_phase(PG8_LAS unsigned char* lds, const Gemm g, const Sched& S, const Epi& E) {
    const int tid = opaque_tid(), wid = __builtin_amdgcn_readfirstlane(tid >> 6), lane = tid & 63, wr = wid >> 2, wc = wid & 3, fr = lane & 15, fq = lane >> 4;
    const int K = g.K, nt = K / BK;
    unsigned voffA[2], voffB[2];
#pragma unroll
    for (int i = 0; i < 2; ++i) { int R, C; stage_rc(tid * 16 + i * 8192, R, C); const int Rb = E.perm ? ((R & ~31) + perm32(R & 31)) : R;
        voffA[i] = (unsigned)(R * g.lda + C) * 2u; voffB[i] = (unsigned)(Rb * g.ldb + C) * 2u; }
    const size_t kstep = (size_t)(BK * 2);
    const size_t hstepA = (size_t)HALF * g.lda * 2, hstepB = (size_t)HALF * g.ldb * 2;
    const size_t tstepA = 2 * hstepA, tstepB = 2 * hstepB, pnoffA = (size_t)g.a_pn_off * 2;
    const unsigned ldsw = (unsigned)wid * 1024u;
    const int aoff = lds_byte(wr * 64 + fr, fq * 8), boff = lds_byte(wc * 32 + fr, fq * 8);
#define PG8_SA(b, h) (((b) * 2 + (h)) * HTB)
#define PG8_SB(b, h) ((4 + (b) * 2 + (h)) * HTB)
#define PG8_STAGE(bufoff, gbase, voff) do { _Pragma("unroll") for (int _i = 0; _i < 2; ++_i) \
        __builtin_amdgcn_global_load_lds((const unsigned*)((const char*)(gbase) + (voff)[_i]), (PG8_LAS unsigned*)(lds + (bufoff) + ldsw + _i * 8192), 16, 0, 0); } while (0)
#define PG8_LDA(dst, b, h) do { _Pragma("unroll") for (int m = 0; m < 4; ++m) _Pragma("unroll") for (int k = 0; k < 2; ++k) dst[m][k] = *(const PG8_LAS bf16x8*)(lds + PG8_SA(b, h) + aoff + m * 2048 + k * 1024); } while (0)
#define PG8_LDB(dst, b, h) do { _Pragma("unroll") for (int n = 0; n < 2; ++n) _Pragma("unroll") for (int k = 0; k < 2; ++k) dst[n][k] = *(const PG8_LAS bf16x8*)(lds + PG8_SB(b, h) + boff + n * 2048 + k * 1024); } while (0)
#define PG8_MMA(ai, bj, At, Bt) do { __builtin_amdgcn_s_setprio(1); _Pragma("unroll") for (int m = 0; m < 4; ++m) _Pragma("unroll") for (int n = 0; n < 2; ++n) _Pragma("unroll") for (int k = 0; k < 2; ++k) \
        acc[ai][bj][m][n] = __builtin_amdgcn_mfma_f32_16x16x32_bf16(Bt[n][k], At[m][k], acc[ai][bj][m][n], 0, 0, 0); __builtin_amdgcn_s_setprio(0); } while (0)
#define PG8_WAIT_V(n) asm volatile("s_waitcnt vmcnt(" #n ")" ::: "memory")
#define PG8_WAIT_L(n) asm volatile("s_waitcnt lgkmcnt(" #n ")" ::: "memory")
#define PG8_BAR __builtin_amdgcn_s_barrier()
#define PG8_SCHED __builtin_amdgcn_sched_barrier(0)
    Unit cur, nxt; int ui = 0;
    if (!S.next(0, cur)) return;
    f32x4 acc[2][2][4][2];
#pragma unroll
    for (int a = 0; a < 2; ++a)
#pragma unroll
        for (int b = 0; b < 2; ++b)
#pragma unroll
            for (int m = 0; m < 4; ++m)
#pragma unroll
                for (int n = 0; n < 2; ++n) acc[a][b][m][n] = (f32x4){0.f, 0.f, 0.f, 0.f};
    bf16x8 At[4][2], B0[2][2], B1[2][2];
    const char* cA = (const char*)g.A + (size_t)cur.pm * tstepA + (size_t)cur.pn * pnoffA; const char* cB = (const char*)g.Bt + (size_t)cur.pn * tstepB;
    S.a_ready(cur);
    if constexpr (SP2) {
        PG8_STAGE(PG8_SB(0, 0), cB, voffB); PG8_STAGE(PG8_SB(0, 1), cB + hstepB, voffB); PG8_STAGE(PG8_SA(0, 0), cA, voffA); PG8_STAGE(PG8_SA(0, 1), cA + hstepA, voffA);
        if (wr == 1) PG8_BAR;
        PG8_WAIT_V(2); PG8_BAR;
        PG8_STAGE(PG8_SB(1, 0), cB + kstep, voffB); PG8_STAGE(PG8_SA(1, 0), cA + kstep, voffA); PG8_STAGE(PG8_SB(1, 1), cB + hstepB + kstep, voffB);
        PG8_WAIT_V(6); PG8_BAR;
    } else {
        PG8_STAGE(PG8_SB(0, 0), cB, voffB); PG8_STAGE(PG8_SA(0, 0), cA, voffA); PG8_STAGE(PG8_SB(0, 1), cB + hstepB, voffB); PG8_STAGE(PG8_SA(0, 1), cA + hstepA, voffA);
        if (wr == 1) PG8_BAR;
        PG8_WAIT_V(4); PG8_BAR;
        PG8_STAGE(PG8_SB(1, 0), cB + kstep, voffB); PG8_STAGE(PG8_SA(1, 0), cA + kstep, voffA); PG8_STAGE(PG8_SB(1, 1), cB + hstepB + kstep, voffB);
        PG8_WAIT_V(6); PG8_BAR;
    }
    for (;;) {
        const bool has_next = S.next(ui + 1, nxt);
        const char* nA = has_next ? (const char*)g.A + (size_t)nxt.pm * tstepA + (size_t)nxt.pn * pnoffA : cA; const char* nB = has_next ? (const char*)g.Bt + (size_t)nxt.pn * tstepB : cB;
        for (int t = 0; t < nt; t += 2) {
            const bool last = (t == nt - 2);
            const char* a1 = cA + (size_t)(t + 1) * kstep;
            const char* a2 = last ? nA : cA + (size_t)(t + 2) * kstep; const char* b2 = last ? nB : cB + (size_t)(t + 2) * kstep;
            const char* a3 = a2 + kstep; const char* b3 = b2 + kstep;
            if (last && has_next) S.a_ready(nxt);
            if constexpr (SP2) {
            PG8_LDB(B0, 0, 0); PG8_LDB(B1, 0, 1); PG8_SCHED; PG8_LDA(At, 0, 0); PG8_STAGE(PG8_SA(1, 1), a1 + hstepA, voffA);
            PG8_WAIT_V(8); PG8_WAIT_L(0); PG8_BAR; PG8_MMA(0, 0, At, B0); PG8_MMA(0, 1, At, B1); PG8_BAR; PG8_SCHED;
            PG8_LDA(At, 0, 1); PG8_STAGE(PG8_SB(0, 0), b2, voffB); PG8_STAGE(PG8_SB(0, 1), b2 + hstepB, voffB); PG8_STAGE(PG8_SA(0, 0), a2, voffA);
            PG8_WAIT_V(8); PG8_WAIT_L(0); PG8_BAR; PG8_MMA(1, 0, At, B0); PG8_MMA(1, 1, At, B1); PG8_BAR; PG8_SCHED;
            PG8_LDB(B0, 1, 0); PG8_LDB(B1, 1, 1); PG8_SCHED; PG8_LDA(At, 1, 0); PG8_STAGE(PG8_SA(0, 1), a2 + hstepA, voffA);
            PG8_WAIT_V(8); PG8_WAIT_L(0); PG8_BAR; PG8_MMA(0, 0, At, B0); PG8_MMA(0, 1, At, B1); PG8_BAR; PG8_SCHED;
            PG8_LDA(At, 1, 1); PG8_STAGE(PG8_SB(1, 0), b3, voffB); PG8_STAGE(PG8_SB(1, 1), b3 + hstepB, voffB); PG8_STAGE(PG8_SA(1, 0), a3, voffA);
            PG8_WAIT_V(8); PG8_WAIT_L(0); PG8_BAR; PG8_MMA(1, 0, At, B0); PG8_MMA(1, 1, At, B1); PG8_BAR; PG8_SCHED;
            } else {
            PG8_LDB(B0, 0, 0); PG8_SCHED; PG8_LDA(At, 0, 0); PG8_STAGE(PG8_SA(1, 1), a1 + hstepA, voffA);
            PG8_WAIT_L(8); PG8_BAR; PG8_WAIT_L(0); PG8_MMA(0, 0, At, B0); PG8_BAR; PG8_SCHED;
            PG8_LDB(B1, 0, 1); PG8_STAGE(PG8_SB(0, 0), b2, voffB);
            PG8_BAR; PG8_WAIT_L(0); PG8_MMA(0, 1, At, B1); PG8_BAR;
            PG8_LDA(At, 0, 1); PG8_STAGE(PG8_SA(0, 0), a2, voffA);
            PG8_BAR; PG8_WAIT_L(0); PG8_MMA(1, 0, At, B0); PG8_BAR; PG8_SCHED;
            PG8_STAGE(PG8_SB(0, 1), b2 + hstepB, voffB);
            PG8_WAIT_V(6); PG8_BAR; PG8_MMA(1, 1, At, B1); PG8_BAR;
            PG8_LDB(B0, 1, 0); PG8_SCHED; PG8_LDA(At, 1, 0); PG8_STAGE(PG8_SA(0, 1), a2 + hstepA, voffA);
            PG8_WAIT_L(8); PG8_BAR; PG8_WAIT_L(0); PG8_MMA(0, 0, At, B0); PG8_BAR; PG8_SCHED;
            PG8_LDB(B1, 1, 1); PG8_STAGE(PG8_SB(1, 0), b3, voffB);
            PG8_BAR; PG8_WAIT_L(0); PG8_MMA(0, 1, At, B1); PG8_BAR;
            PG8_LDA(At, 1, 1); PG8_STAGE(PG8_SA(1, 0), a3, voffA);
            PG8_BAR; PG8_WAIT_L(0); PG8_MMA(1, 0, At, B0); PG8_BAR; PG8_SCHED;
            PG8_STAGE(PG8_SB(1, 1), b3 + hstepB, voffB);
            PG8_WAIT_V(6); PG8_BAR; PG8_MMA(1, 1, At, B1); PG8_BAR;
            }
        }
        if constexpr (ALIGN_EPI) { if (wr == 0) PG8_BAR; }
        E(acc, cur, wr, wc, fr, fq); S.done(cur);
        if (!has_next) break;
#pragma unroll
        for (int a = 0; a < 2; ++a)
#pragma unroll
            for (int b = 0; b < 2; ++b)
#pragma unroll
                for (int m = 0; m < 4; ++m)
#pragma unroll
                    for (int n = 0; n < 2; ++n) acc[a][b][m][n] = (f32x4){0.f, 0.f, 0.f, 0.f};
        cur = nxt; cA = nA; cB = nB; ++ui;
        if constexpr (ALIGN_EPI) { if (wr == 1) PG8_BAR; }
    }
    PG8_WAIT_V(0);
    if constexpr (!ALIGN_EPI) { if (wr == 0) PG8_BAR; }
    PG8_BAR;
#undef PG8_SA
#undef PG8_SB
#undef PG8_STAGE
#undef PG8_LDA
#undef PG8_LDB
#undef PG8_MMA
#undef PG8_WAIT_V
#undef PG8_WAIT_L
#undef PG8_BAR
#undef PG8_SCHED
}
}

constexpr int NWAVES = 8;
constexpr int N_LAUNCHES = MK_N_LAUNCHES;
constexpr int PER_PHASE = 15;
constexpr int D = 1024, FF = 4096, NP = 16384, NS = 1024, M = NP + NS, NSEQ = 136, SEQ = 2048, DSEQ = 8;
constexpr int MODW = 12288;
constexpr float EPS = 1e-6f;

constexpr size_t OUT_Y = 0, OUT_PP = (size_t)M * D, OUT_PS = OUT_PP + 8 * 15 * 1024, OUT_VP = OUT_PS + 128 * 15 * 1024, OUT_VS = OUT_VP + 8 * 128 * 1024, OUT_END = OUT_VS + 128 * 8 * 1024;

constexpr size_t MiB = 1u << 20;
constexpr size_t WS_CTL = 0, CTL_ZERO_BYTES = 1 * MiB;
constexpr size_t WS_VSTAT = 512 * 1024;
constexpr size_t WS_MOD = 1 * MiB;
constexpr size_t WS_RSTD0 = 14 * MiB;
constexpr size_t WS_SC = 15 * MiB;
constexpr size_t WS_WP = 16 * MiB;
constexpr size_t WS_WSP = 17 * MiB;
constexpr size_t WS_WOUT = 18 * MiB;
constexpr size_t WS_WIN = 20 * MiB;
constexpr size_t WS_W1 = 24 * MiB;
constexpr size_t WS_W2 = 40 * MiB;
constexpr size_t WS_H = 56 * MiB;
constexpr size_t WS_A2 = 90 * MiB;
constexpr size_t WS_WADA = WS_A2;
constexpr size_t WS_U = WS_A2, WS_V = WS_A2 + 34 * MiB, WS_G = WS_A2 + 68 * MiB;
constexpr size_t WS_END = 226 * MiB;
constexpr int CW_TMO = 0, CW_BAR = 4096;

constexpr int RING_OFF = 0, RING_BYTES = 131072;
constexpr int LDSCTL_OFF = RING_BYTES, MISC_OFF = LDSCTL_OFF + 320;
constexpr int LDS_BYTES = 147456;

#define GAS __attribute__((address_space(1)))
#define LAS __attribute__((address_space(3)))
typedef unsigned short bf16;
typedef unsigned v4u __attribute__((ext_vector_type(4)));
typedef unsigned v2u __attribute__((ext_vector_type(2)));
typedef float f32x4 __attribute__((ext_vector_type(4)));
typedef float f32x16 __attribute__((ext_vector_type(16)));
typedef short bf16x8 __attribute__((ext_vector_type(8)));
typedef GAS unsigned gu32;
#define RLX_AGENT __ATOMIC_RELAXED, __HIP_MEMORY_SCOPE_AGENT
#define LDS_WAIT() asm volatile("s_waitcnt lgkmcnt(0)" ::: "memory")
#define VM_WAIT() asm volatile("s_waitcnt vmcnt(0)" ::: "memory")
__device__ __forceinline__ unsigned f2bf(float f) { unsigned u = __builtin_bit_cast(unsigned, f); return (u + 0x7fffu + ((u >> 16) & 1u)) >> 16; }
__device__ __forceinline__ unsigned pk2(float lo, float hi) { return f2bf(lo) | (f2bf(hi) << 16); }
__device__ __forceinline__ float bf2f(unsigned short b) { return __builtin_bit_cast(float, (unsigned)b << 16); }
__device__ __forceinline__ int seq_of_row(int row) { return row < NP ? (row >> 11) : (8 + ((row - NP) >> 3)); }

#define XB_TMO      128
#define XB_XCNT(j)  (256  + 64 * (j))
#define XB_XSUB(j)  (1280 + 64 * (j))
#define XB_XGEN(j)  (2304 + 64 * (j))
#define XB_TOP      3328
#define XB_TOPGEN   3392
#define XCD_BAR_WORDS 3456
#define XB_SPIN_CAP (1u << 18)
__device__ __forceinline__ unsigned xb_ld(unsigned* p)              { return __hip_atomic_load(p, __ATOMIC_RELAXED, __HIP_MEMORY_SCOPE_AGENT); }
__device__ __forceinline__ unsigned xb_add(unsigned* p, unsigned v) { return __hip_atomic_fetch_add(p, v, __ATOMIC_RELAXED, __HIP_MEMORY_SCOPE_AGENT); }
__device__ __forceinline__ unsigned xb_xcc_id() { return (unsigned)__builtin_amdgcn_s_getreg((3 << 11) | 20) & 0xFu; }
#define XB_SPIN(cond, bar) do { unsigned _sp = 0; while (cond) { __builtin_amdgcn_s_sleep(1); \
    if ((++_sp & 255u) == 0u) { if (xb_ld(&(bar)[XB_TMO])) break; if (_sp > XB_SPIN_CAP) { atomicAdd(&(bar)[XB_TMO], 1u); break; } } } } while (0)
struct XcdBarrier { unsigned* bar; unsigned x; volatile LAS unsigned* st; };
__device__ __forceinline__ XcdBarrier xcd_barrier_post(unsigned* bar, volatile LAS unsigned* st) {
    XcdBarrier b; b.bar = bar; b.x = xb_xcc_id(); b.st = st;
    if (threadIdx.x == 0) (void)xb_add(&bar[XB_XCNT(b.x)], 1u);
    return b;
}
__device__ __forceinline__ void xcd_barrier_complete(unsigned* bar, unsigned x, unsigned& nloc, unsigned& nx) {
    const unsigned G = gridDim.x * gridDim.y * gridDim.z;
    unsigned sum, cnt, mine, sp = 0u;
    for (;;) {
        sum = 0u; cnt = 0u; mine = 0u;
#pragma unroll
        for (unsigned j = 0; j < 16; ++j) { const unsigned c = xb_ld(&bar[XB_XCNT(j)]); sum += c; cnt += (c > 0u) ? 1u : 0u; mine = (j == x) ? c : mine; }
        if (sum == G) break;
        __builtin_amdgcn_s_sleep(1);
        if ((++sp & 255u) == 0u) { if (xb_ld(&bar[XB_TMO])) break; if (sp > XB_SPIN_CAP) { atomicAdd(&bar[XB_TMO], 1u); break; } }
    }
    nloc = mine > 0u ? mine : 1u; nx = cnt > 0u ? cnt : 1u;
}
__device__ __forceinline__ void xcd_barrier(const XcdBarrier& b) {
    asm volatile("s_waitcnt vmcnt(0)" ::: "memory");
    __syncthreads();
    if (threadIdx.x == 0) {
        unsigned* bar = b.bar;
        __builtin_amdgcn_s_waitcnt(0);
        unsigned nloc = b.st[0], nx = b.st[1];
        if (nloc == 0u) { xcd_barrier_complete(bar, b.x, nloc, nx); b.st[0] = nloc; b.st[1] = nx; }
        const unsigned old = xb_add(&bar[XB_XSUB(b.x)], 1u);
        const unsigned gen = old / nloc;
        if (old + 1u == (gen + 1u) * nloc) {
            __builtin_amdgcn_fence(__ATOMIC_RELEASE, "agent");
            asm volatile("s_waitcnt vmcnt(0)" ::: "memory");
            const unsigned og = xb_add(&bar[XB_TOP], 1u);
            const unsigned tg = og / nx;
            if (og + 1u == (tg + 1u) * nx) xb_add(&bar[XB_TOPGEN], 1u);
            else XB_SPIN(xb_ld(&bar[XB_TOPGEN]) == tg, bar);
            __builtin_amdgcn_fence(__ATOMIC_ACQUIRE, "agent");
            xb_add(&bar[XB_XGEN(b.x)], 1u);
            asm volatile("s_waitcnt vmcnt(0)" ::: "memory");
        } else {
            XB_SPIN(xb_ld(&bar[XB_XGEN(b.x)]) == gen, bar);
            __builtin_amdgcn_fence(__ATOMIC_ACQUIRE, "agent");
            asm volatile("s_waitcnt vmcnt(0)" ::: "memory");
        }
    }
    __syncthreads();
}

using pg8::Unit; using pg8::HALF; using pg8::BM;
struct EpiAll {
    int mode; bool perm;
    float* F0; const float* P0; const float* P1; const float* P2; const float* P3; bf16* B0; bf16* B1;
    __device__ __forceinline__ void operator()(const f32x4 (&acc)[2][2][4][2], const Unit& u, int wr, int wc, int fr, int fq) const {
        const int row0 = u.pm * BM + wr * 64 + fr;
        if (mode == 0) {
            const int col0 = u.pn * BM + wc * 32 + 4 * fq;
            f32x4 bv[2][2];
#pragma unroll
            for (int bj = 0; bj < 2; ++bj)
#pragma unroll
                for (int n = 0; n < 2; ++n) bv[bj][n] = *(const f32x4*)(P0 + col0 + bj * HALF + n * 16);
#pragma unroll
            for (int ai = 0; ai < 2; ++ai)
#pragma unroll
                for (int m = 0; m < 4; ++m) { float* rowp = F0 + (size_t)(row0 + ai * HALF + m * 16) * MODW + col0;
#pragma unroll
                    for (int bj = 0; bj < 2; ++bj)
#pragma unroll
                        for (int n = 0; n < 2; ++n) *(f32x4*)(rowp + bj * HALF + n * 16) = acc[ai][bj][m][n] + bv[bj][n]; }
        } else if (mode == 1) {
            const int col0 = u.pn * BM + wc * 32 + 4 * fq;
            f32x4 ps[2][2];
#pragma unroll
            for (int bj = 0; bj < 2; ++bj)
#pragma unroll
                for (int n = 0; n < 2; ++n) ps[bj][n] = *(const f32x4*)(P1 + col0 + bj * HALF + n * 16);
#pragma unroll
            for (int ai = 0; ai < 2; ++ai)
#pragma unroll
                for (int m = 0; m < 4; ++m) { const int row = row0 + ai * HALF + m * 16; const int seq = seq_of_row(row);
                    const float* xr = (row < NP ? P2 + (size_t)row * D : P3 + (size_t)(row - NP) * D) + col0; const float* gr = P0 + (size_t)seq * MODW + col0; float* orow = F0 + (size_t)row * D + col0;
#pragma unroll
                    for (int bj = 0; bj < 2; ++bj)
#pragma unroll
                        for (int n = 0; n < 2; ++n) { const int o = bj * HALF + n * 16; const f32x4 xv = *(const f32x4*)(xr + o), gv = *(const f32x4*)(gr + o);
                            *(f32x4*)(orow + o) = xv + gv * ps[bj][n] * acc[ai][bj][m][n]; } }
        } else if (mode == 2) {
            const int col0 = u.pn * BM + wc * 32 + 4 * fq;
#pragma unroll
            for (int ai = 0; ai < 2; ++ai)
#pragma unroll
                for (int m = 0; m < 4; ++m) { const int row = row0 + ai * HALF + m * 16; const int seq = seq_of_row(row);
                    const float* gr = P0 + (size_t)seq * MODW + col0; float* orow = F0 + (size_t)row * D + col0;
#pragma unroll
                    for (int bj = 0; bj < 2; ++bj)
#pragma unroll
                        for (int n = 0; n < 2; ++n) { const int o = bj * HALF + n * 16; const f32x4 xv = *(const f32x4*)(orow + o), gv = *(const f32x4*)(gr + o);
                            *(f32x4*)(orow + o) = xv + gv * acc[ai][bj][m][n]; } }
        } else if (mode == 3) {
            const int col0 = u.pn * BM + wc * 32 + 8 * fq;
#pragma unroll
            for (int ai = 0; ai < 2; ++ai)
#pragma unroll
                for (int m = 0; m < 4; ++m) { bf16* rowp = B0 + (size_t)(row0 + ai * HALF + m * 16) * FF + col0;
#pragma unroll
                    for (int bj = 0; bj < 2; ++bj) { f32x4 v0 = acc[ai][bj][m][0], v1 = acc[ai][bj][m][1];
#pragma unroll
                        for (int j = 0; j < 4; ++j) { const float a = fmaxf(v0[j], 0.f), b = fmaxf(v1[j], 0.f); v0[j] = a * a; v1[j] = b * b; }
                        v4u w; w.x = pg8::cvt_pk_bf16(v0[0], v0[1]); w.y = pg8::cvt_pk_bf16(v0[2], v0[3]); w.z = pg8::cvt_pk_bf16(v1[0], v1[1]); w.w = pg8::cvt_pk_bf16(v1[2], v1[3]);
                        *(v4u*)(rowp + bj * HALF) = w; } }
        } else {
            const bool isv = u.pn >= 4;
            const int colt = (u.pn & 3) * BM, col0 = colt + wc * 32 + 8 * fq, bcol0 = u.pn * BM + wc * 32 + 8 * fq;
            bf16* base = isv ? B1 : B0;
            f32x4 bv[2][2];
#pragma unroll
            for (int bj = 0; bj < 2; ++bj)
#pragma unroll
                for (int n = 0; n < 2; ++n) bv[bj][n] = *(const f32x4*)(P0 + bcol0 + bj * HALF + 4 * n);
#pragma unroll
            for (int ai = 0; ai < 2; ++ai)
#pragma unroll
                for (int m = 0; m < 4; ++m) { const int row = row0 + ai * HALF + m * 16; bf16* rowp = base + (size_t)row * D + col0; float s = 0.f, q = 0.f;
#pragma unroll
                    for (int bj = 0; bj < 2; ++bj) { f32x4 v0 = acc[ai][bj][m][0] + bv[bj][0], v1 = acc[ai][bj][m][1] + bv[bj][1];
                        pg8::f32x2 a = pg8::gelu_pk((pg8::f32x2){v0[0], v0[1]}), b = pg8::gelu_pk((pg8::f32x2){v0[2], v0[3]}), c = pg8::gelu_pk((pg8::f32x2){v1[0], v1[1]}), d = pg8::gelu_pk((pg8::f32x2){v1[2], v1[3]});
                        s += (a.x + a.y) + (b.x + b.y) + (c.x + c.y) + (d.x + d.y);
                        q += (a.x * a.x + a.y * a.y) + (b.x * b.x + b.y * b.y) + (c.x * c.x + c.y * c.y) + (d.x * d.x + d.y * d.y);
                        v4u w; w.x = pg8::cvt_pk_bf16(a.x, a.y); w.y = pg8::cvt_pk_bf16(b.x, b.y); w.z = pg8::cvt_pk_bf16(c.x, c.y); w.w = pg8::cvt_pk_bf16(d.x, d.y);
                        *(v4u*)(rowp + bj * HALF) = w; }
                    if (isv) { s += __shfl_xor(s, 16); s += __shfl_xor(s, 32); q += __shfl_xor(q, 16); q += __shfl_xor(q, 32);
                        if (fq == 0) { atomicAdd(F0 + 2 * (size_t)row, s); atomicAdd(F0 + 2 * (size_t)row + 1, q); } } }
        }
    }
};

struct Frame {
    LAS unsigned char* lds;
    volatile LAS unsigned* MISC;
    gu32* ctl;
    int tid, lane, wave;
    int vcu, G;
};
struct Args { const float* in[20]; float* out; unsigned char* ws; int ph_lo, ph_hi; };
__device__ __forceinline__ void frame_refresh(Frame& F) { F.tid = opaque_tid(); F.lane = F.tid & 63; F.wave = __builtin_amdgcn_readfirstlane(F.tid >> 6); }

__device__ __forceinline__ float wave_sum(float v) {
#pragma unroll
    for (int o = 1; o < 64; o <<= 1) v += __shfl_xor(v, o);
    return v;
}
__device__ __forceinline__ void p0_transpose_item(const float* W, int K, int N, bf16* WT, int row_off, LAS float* scr, int item, int lane) {
    const int nblk = N / 32, kb = item / nblk, nb = item % nblk, k0 = 64 * kb, n0 = 32 * nb;
#pragma unroll 8
    for (int i = 0; i < 32; ++i) { const int kk = 2 * i + (lane >> 5); scr[kk * 33 + (lane & 31)] = W[(size_t)(k0 + kk) * N + n0 + (lane & 31)]; }
    LDS_WAIT(); asm volatile("" ::: "memory");
    const int c = lane & 7;
#pragma unroll
    for (int j = 0; j < 4; ++j) { const int n = (lane >> 3) + 8 * j; const LAS float* s = scr + (8 * c) * 33 + n;
        v4u o; o.x = pk2(s[0 * 33], s[1 * 33]); o.y = pk2(s[2 * 33], s[3 * 33]); o.z = pk2(s[4 * 33], s[5 * 33]); o.w = pk2(s[6 * 33], s[7 * 33]);
        *(GAS v4u*)(WT + (size_t)(row_off + n0 + n) * K + k0 + 8 * c) = o; }
    LDS_WAIT(); asm volatile("" ::: "memory");
}

__device__ __forceinline__ void p0_prologue(Frame& F, const Args& a) {
    frame_refresh(F);
    unsigned char* ws = a.ws;
    LAS float* scr = (LAS float*)(F.lds + RING_OFF + F.wave * 16384);
    const int gw = F.vcu * NWAVES + F.wave, NGW = F.G * NWAVES;
    constexpr int I_ADA = 16 * 192, I_POOL = 4 * 8, I_IN = 16 * 64, I_OUT = 16 * 32, I_W1 = 16 * 128, I_W2 = 64 * 32;
    constexpr int NITEMS = 2 * I_ADA + 4 * I_POOL + I_IN + I_OUT + 2 * I_W1 + 2 * I_W2;
    for (int it = gw; it < NITEMS; it += NGW) {
        int r = it;
        if (r < 2 * I_ADA) { const int l = r / I_ADA; p0_transpose_item(a.in[6] + (size_t)l * 1024 * 6144, 1024, 6144, (bf16*)(ws + WS_WADA), l * 6144, scr, r % I_ADA, F.lane); continue; } r -= 2 * I_ADA;
        if (r < 4 * I_POOL) { const int g = r / I_POOL; p0_transpose_item(a.in[8] + (size_t)g * 65536, 256, 256, (bf16*)(ws + WS_WP), g * 256, scr, r % I_POOL, F.lane); continue; } r -= 4 * I_POOL;
        if (r < I_IN) { p0_transpose_item(a.in[10], 1024, 2048, (bf16*)(ws + WS_WIN), 0, scr, r, F.lane); continue; } r -= I_IN;
        if (r < I_OUT) { p0_transpose_item(a.in[16], 1024, 1024, (bf16*)(ws + WS_WOUT), 0, scr, r, F.lane); continue; } r -= I_OUT;
        if (r < 2 * I_W1) { const int l = r / I_W1; p0_transpose_item(a.in[17] + (size_t)l * 1024 * 4096, 1024, 4096, (bf16*)(ws + WS_W1) + (size_t)l * 4096 * 1024, 0, scr, r % I_W1, F.lane); continue; } r -= 2 * I_W1;
        { const int l = r / I_W2; p0_transpose_item(a.in[18] + (size_t)l * 4096 * 1024, 4096, 1024, (bf16*)(ws + WS_W2) + (size_t)l * 4096 * 1024, 0, scr, r % I_W2, F.lane); }
    }
    {
        const float* wsp = a.in[14]; bf16* o = (bf16*)(ws + WS_WSP);
        for (int i = (F.vcu * NWAVES + F.wave) * 64 + F.lane; i < 2 * 65536; i += NGW * 64) {
            const int var = i >> 16, e = i & 65535, g = e >> 14, t = (e >> 7) & 127, s = e & 127;
            float v = 0.f;
            if (var == 0) { if (s <= t) v = wsp[(size_t)g * 16384 + t * 128 + s]; }
            else { if ((t >> 3) == (s >> 3) && (s & 7) <= (t & 7)) v = wsp[(size_t)g * 16384 + (t & 7) * 128 + (s & 7)]; }
            o[i] = (bf16)f2bf(v);
        }
    }
    float* rstd0 = (float*)(ws + WS_RSTD0);
    for (int m = gw; m < M; m += NGW) {
        const float* xrow = m < NP ? a.in[0] + (size_t)m * D : a.in[1] + (size_t)(m - NP) * D;
        const GAS f32x4* xr = (const GAS f32x4*)xrow + F.lane; float s = 0.f;
#pragma unroll
        for (int j = 0; j < 4; ++j) { const f32x4 v = xr[64 * j]; s += (v.x * v.x + v.y * v.y) + (v.z * v.z + v.w * v.w); }
        s = wave_sum(s);
        if (F.lane == 0) rstd0[m] = 1.0f / sqrtf(s * (1.0f / D) + EPS);
    }
    bf16* sc = (bf16*)(ws + WS_SC);
    for (int m = gw; m < 256; m += NGW) {
        GAS unsigned long long* o8 = (GAS unsigned long long*)(sc + (size_t)m * D) + F.lane;
        if (m < NSEQ) {
            const float* crow = m < 8 ? a.in[2] + (size_t)m * D : a.in[3] + (size_t)(m - 8) * D;
            const GAS f32x4* cr = (const GAS f32x4*)crow + F.lane;
#pragma unroll
            for (int j = 0; j < 4; ++j) { f32x4 v = cr[64 * j];
#pragma unroll
                for (int e = 0; e < 4; ++e) v[e] = v[e] / (1.0f + __expf(-v[e]));
                o8[64 * j] = (unsigned long long)pk2(v.x, v.y) | ((unsigned long long)pk2(v.z, v.w) << 32); }
        } else {
#pragma unroll
            for (int j = 0; j < 4; ++j) o8[64 * j] = 0ull;
        }
    }
}

__device__ __forceinline__ void pool_prepass(Frame& F, const Args& a) {
    frame_refresh(F);
    unsigned char* ws = a.ws;
    const float* rstd0 = (const float*)(ws + WS_RSTD0); const float* MOD = (const float*)(ws + WS_MOD);
    const float* ng = a.in[5];
    bf16* Dm = (bf16*)(ws + WS_H);
    LAS float* hb = (LAS float*)(F.lds + RING_OFF);
    for (int u = F.vcu; u < NP / 64; u += F.G) {
        const int b = u >> 5, t0 = (u & 31) * 64, seq = b; const bool lastu = (t0 == SEQ - 64);
        const float* sh = MOD + (size_t)seq * MODW + 0 * 1024; const float* scp = MOD + (size_t)seq * MODW + 1 * 1024;
        for (int g = 0; g < 4; ++g) {
            const int w = 2 << g, c4 = 256 * g + 4 * F.lane;
            const f32x4 gv = *(const f32x4*)(ng + c4), sv = *(const f32x4*)(scp + c4), hv = *(const f32x4*)(sh + c4);
            const f32x4 gm = gv * (sv + 1.0f);
            for (int j = F.wave; j < 79; j += NWAVES) {
                const int t = t0 - 15 + j; f32x4 h = (f32x4){0.f, 0.f, 0.f, 0.f};
                if (t >= 0) { const int row = b * SEQ + t; const f32x4 xv = *(const f32x4*)(a.in[0] + (size_t)row * D + c4); h = xv * rstd0[row] * gm + hv;
                    if (lastu && j >= 64) *(f32x4*)(a.out + OUT_PP + ((size_t)b * 15 + (j - 64)) * D + c4) = h; }
                *(LAS f32x4*)(hb + j * 256 + 4 * F.lane) = h;
            }
            __syncthreads();
            {
                const int col = F.tid & 255, half = F.tid >> 8; float s = 0.f;
                const int j0 = half * 32 + 15;
                for (int q = 1; q < w; ++q) s += hb[(j0 - q) * 256 + col];
                for (int i = 0; i < 32; ++i) { const int j = j0 + i, t = t0 + half * 32 + i; const float cur = hb[j * 256 + col]; s += cur;
                    const int cnt = (t + 1) < w ? (t + 1) : w; const float d = s / (float)cnt - cur; s -= hb[(j - w + 1) * 256 + col];
                    Dm[(size_t)(b * SEQ + t) * D + 256 * g + col] = (bf16)f2bf(d); }
            }
            __syncthreads();
        }
    }
    for (int s_ = F.vcu; s_ < 128; s_ += F.G) {
        const int seq = 8 + s_;
        const float* sh = MOD + (size_t)seq * MODW + 0 * 1024; const float* scp = MOD + (size_t)seq * MODW + 1 * 1024;
        for (int j = F.wave; j < 23; j += NWAVES) {
#pragma unroll
            for (int q = 0; q < 4; ++q) { const int c4 = 256 * q + 4 * F.lane; f32x4 h;
                if (j < 15) h = *(const f32x4*)(a.in[4] + ((size_t)s_ * 15 + j) * D + c4);
                else { const int row = NP + s_ * 8 + (j - 15); const f32x4 xv = *(const f32x4*)(a.in[1] + (size_t)(row - NP) * D + c4);
                    const f32x4 gv = *(const f32x4*)(ng + c4), sv = *(const f32x4*)(scp + c4), hv = *(const f32x4*)(sh + c4); h = xv * rstd0[row] * (gv * (sv + 1.0f)) + hv; }
                if (j >= 8) *(f32x4*)(a.out + OUT_PS + ((size_t)s_ * 15 + (j - 8)) * D + c4) = h;
                *(LAS f32x4*)(hb + j * 1024 + c4) = h; }
        }
        __syncthreads();
        for (int col = F.tid; col < 1024; col += NWAVES * 64) { const int w = 2 << (col >> 8);
            for (int t = 0; t < 8; ++t) { const int j = 15 + t; float s = 0.f;
                for (int q = 0; q < w; ++q) s += hb[(j - q) * 1024 + col];
                const float d = s / (float)w - hb[j * 1024 + col];
                Dm[(size_t)(NP + s_ * 8 + t) * D + col] = (bf16)f2bf(d); } }
        __syncthreads();
    }
}

__device__ __forceinline__ void norm_rows(Frame& F, const float* X, const float* g, const float* sh_base, const float* sc_base, bf16* H) {
    frame_refresh(F);
    const int gw = F.vcu * NWAVES + F.wave, NGW = F.G * NWAVES;
    for (int m = gw; m < M; m += NGW) {
        const int seq = seq_of_row(m);
        const GAS f32x4* xr = (const GAS f32x4*)(X + (size_t)m * D) + F.lane; f32x4 v[4]; float s = 0.f;
#pragma unroll
        for (int j = 0; j < 4; ++j) { v[j] = xr[64 * j]; s += (v[j].x * v[j].x + v[j].y * v[j].y) + (v[j].z * v[j].z + v[j].w * v[j].w); }
        const float rstd = 1.0f / sqrtf(wave_sum(s) * (1.0f / D) + EPS);
        GAS unsigned long long* o8 = (GAS unsigned long long*)(H + (size_t)m * D) + F.lane;
#pragma unroll
        for (int j = 0; j < 4; ++j) { const int c4 = 4 * F.lane + 256 * j;
            const f32x4 gv = *(const f32x4*)(g + c4), sv = *(const f32x4*)(sc_base + (size_t)seq * MODW + c4), hv = *(const f32x4*)(sh_base + (size_t)seq * MODW + c4);
            const f32x4 h = v[j] * rstd * gv * (sv + 1.0f) + hv;
            o8[64 * j] = (unsigned long long)pk2(h.x, h.y) | ((unsigned long long)pk2(h.z, h.w) << 32); }
    }
}
__device__ __forceinline__ void final_norm(Frame& F, float* X, const float* g) {
    frame_refresh(F);
    const int gw = F.vcu * NWAVES + F.wave, NGW = F.G * NWAVES;
    for (int m = gw; m < M; m += NGW) {
        GAS f32x4* xr = (GAS f32x4*)(X + (size_t)m * D) + F.lane; f32x4 v[4]; float s = 0.f;
#pragma unroll
        for (int j = 0; j < 4; ++j) { v[j] = xr[64 * j]; s += (v[j].x * v[j].x + v[j].y * v[j].y) + (v[j].z * v[j].z + v[j].w * v[j].w); }
        const float rstd = 1.0f / sqrtf(wave_sum(s) * (1.0f / D) + EPS);
#pragma unroll
        for (int j = 0; j < 4; ++j) { const f32x4 gv = *(const f32x4*)(g + 4 * F.lane + 256 * j); xr[64 * j] = v[j] * rstd * gv; }
    }
}

__device__ __forceinline__ void spatial_phase(Frame& F, const Args& a) {
    frame_refresh(F);
    unsigned char* ws = a.ws;
    const bf16* U = (const bf16*)(ws + WS_U); const bf16* V = (const bf16*)(ws + WS_V); bf16* Gm = (bf16*)(ws + WS_G);
    const float* vstat = (const float*)(ws + WS_VSTAT);
    const float* lng = a.in[12]; const float* lnb = a.in[13]; const float* bsp = a.in[15];
    LAS unsigned short* vt = (LAS unsigned short*)(F.lds + RING_OFF);
    const int r = F.lane & 31, h = F.lane >> 5;
    for (int unit = F.vcu; unit < 136 * 4; unit += F.G) {
        const int ch = unit >> 2, g = unit & 3; const bool prompt = ch < 128;
        const int row0 = prompt ? ch * 128 : NP + (ch - 128) * 128;
        const bool is_last = prompt ? ((ch & 15) == 15) : true;
        const bf16* Am = (const bf16*)(ws + WS_WSP) + (prompt ? 0 : 65536) + g * 16384;
        {
            const int c8 = (F.tid & 31) * 8, cg = 256 * g + c8;
            float lg[8], lb[8];
#pragma unroll
            for (int i = 0; i < 8; ++i) { lg[i] = lng[cg + i]; lb[i] = lnb[cg + i]; }
            for (int pass = 0; pass < 8; ++pass) {
                const int rr = pass * 16 + (F.tid >> 5), grow = row0 + rr;
                const v4u raw = *(const v4u*)(V + (size_t)grow * D + cg);
                const float mean = vstat[2 * (size_t)grow] * (1.0f / 1024.0f); float var = vstat[2 * (size_t)grow + 1] * (1.0f / 1024.0f) - mean * mean; var = var < 0.f ? 0.f : var;
                const float rstd = 1.0f / sqrtf(var + EPS);
                float vn[8];
#pragma unroll
                for (int i = 0; i < 4; ++i) { const unsigned wv = raw[i]; vn[2 * i] = (bf2f((unsigned short)(wv & 0xffffu)) - mean) * rstd * lg[2 * i] + lb[2 * i]; vn[2 * i + 1] = (bf2f((unsigned short)(wv >> 16)) - mean) * rstd * lg[2 * i + 1] + lb[2 * i + 1]; }
                if (is_last) {
                    float* op = prompt ? a.out + OUT_VP + ((size_t)(ch >> 4) * 128 + rr) * D + cg : a.out + OUT_VS + (size_t)(grow - NP) * D + cg;
                    *(f32x4*)op = (f32x4){vn[0], vn[1], vn[2], vn[3]}; *(f32x4*)(op + 4) = (f32x4){vn[4], vn[5], vn[6], vn[7]};
                }
                v4u w; w.x = pk2(vn[0], vn[1]); w.y = pk2(vn[2], vn[3]); w.z = pk2(vn[4], vn[5]); w.w = pk2(vn[6], vn[7]);
                *(LAS v4u*)(vt + rr * 256 + c8) = w;
            }
        }
        __syncthreads();
        const int n0 = 32 * F.wave;
        f32x16 acc[4];
#pragma unroll
        for (int mt = 0; mt < 4; ++mt)
#pragma unroll
            for (int i = 0; i < 16; ++i) acc[mt][i] = 0.f;
#pragma unroll
        for (int ks = 0; ks < 8; ++ks) {
            const int k0 = 16 * ks;
            bf16x8 bfr;
#pragma unroll
            for (int j = 0; j < 8; ++j) bfr[j] = (short)vt[(k0 + 8 * h + j) * 256 + n0 + r];
#pragma unroll
            for (int mt = 0; mt < 4; ++mt) {
                if (prompt && k0 >= 32 * (mt + 1)) continue;
                const bf16x8 afr = *(const bf16x8*)(Am + (size_t)(32 * mt + r) * 128 + k0 + 8 * h);
                acc[mt] = __builtin_amdgcn_mfma_f32_32x32x16_bf16(afr, bfr, acc[mt], 0, 0, 0);
            }
        }
#pragma unroll
        for (int mt = 0; mt < 4; ++mt)
#pragma unroll
            for (int i = 0; i < 16; ++i) {
                const int t = 32 * mt + (i & 3) + 8 * (i >> 2) + 4 * h, grow = row0 + t, c = 256 * g + n0 + r;
                const float bias = bsp[g * 128 + (prompt ? t : (t & 7))];
                const float uu = bf2f(U[(size_t)grow * D + c]);
                Gm[(size_t)grow * D + c] = (bf16)f2bf(uu * (acc[mt][i] + bias));
            }
        __syncthreads();
    }
}

__global__ void __launch_bounds__(NWAVES * 64, 2) mk_fwd(Args args) {
    extern __shared__ __attribute__((aligned(16))) unsigned char lds[];
    Frame F;
    F.lds = (LAS unsigned char*)lds;
    F.MISC = (volatile LAS unsigned*)(F.lds + MISC_OFF);
    F.tid = threadIdx.x; F.lane = F.tid & 63; F.wave = __builtin_amdgcn_readfirstlane(F.tid >> 6);
    F.G = gridDim.x; { const int bx = blockIdx.x; F.vcu = (F.G % 8 == 0) ? (bx % 8) * (F.G / 8) + bx / 8 : bx; }
    unsigned char* ws = args.ws;
    F.ctl = (gu32*)(ws + WS_CTL);
    for (int u = F.tid; u < (LDS_BYTES - LDSCTL_OFF) / 4; u += NWAVES * 64) ((LAS unsigned*)(F.lds + LDSCTL_OFF))[u] = 0u;
    __syncthreads();
    XcdBarrier bar; bar.bar = (unsigned*)(F.ctl + CW_BAR); bar.x = 0; bar.st = nullptr;
    if (N_LAUNCHES == 1) bar = xcd_barrier_post((unsigned*)(F.ctl + CW_BAR), F.MISC + 8);
#define GRID_BAR() do { if (N_LAUNCHES == 1) xcd_barrier(bar); } while (0)
    const int lo = args.ph_lo, hi = args.ph_hi;
    float* X = args.out + OUT_Y;
    const float* MOD = (const float*)(ws + WS_MOD);
    bf16* Hb = (bf16*)(ws + WS_H); bf16* A2 = (bf16*)(ws + WS_A2);
    const int bx = (int)blockIdx.x;

    for (int ph = lo; ph < hi; ++ph) {
        if (ph == 0) p0_prologue(F, args);
        else if (ph == 2) pool_prepass(F, args);
        else if (ph == 9) spatial_phase(F, args);
        else if (ph == 14) final_norm(F, X, args.in[19]);
        else if (ph == 4 || ph == 7 || ph == 11) {
            const int l = ph >= 7, sub = ph != 7;
            norm_rows(F, X, args.in[5] + (2 * l + sub) * 1024, MOD + l * 6144 + (sub ? 3 : 0) * 1024, MOD + l * 6144 + (sub ? 4 : 1) * 1024, Hb);
        } else {
            pg8::Gemm g; EpiAll E; int Mr = M, Nc = D;
            E.F0 = X; E.P0 = MOD; E.P1 = nullptr; E.P2 = nullptr; E.P3 = nullptr; E.B0 = A2; E.B1 = nullptr;
            if (ph == 1) { g = pg8::Gemm{(const bf16*)(ws + WS_SC), (const bf16*)(ws + WS_WADA), 1024, 1024, 1024, 0}; Mr = 256; Nc = MODW; E.mode = 0; E.perm = false; E.F0 = (float*)(ws + WS_MOD); E.P0 = args.in[7]; }
            else if (ph == 3) { g = pg8::Gemm{Hb, (const bf16*)(ws + WS_WP), 256, 1024, 256, 256}; E.mode = 1; E.perm = false; E.P0 = MOD + 2 * 1024; E.P1 = args.in[9]; E.P2 = args.in[0]; E.P3 = args.in[1]; }
            else if (ph == 8) { g = pg8::Gemm{Hb, (const bf16*)(ws + WS_WIN), 1024, 1024, 1024, 0}; Nc = 2048; E.mode = 4; E.perm = true; E.F0 = (float*)(ws + WS_VSTAT); E.P0 = args.in[11]; E.B0 = (bf16*)(ws + WS_U); E.B1 = (bf16*)(ws + WS_V); }
            else if (ph == 10) { g = pg8::Gemm{(const bf16*)(ws + WS_G), (const bf16*)(ws + WS_WOUT), 1024, 1024, 1024, 0}; E.mode = 2; E.perm = false; E.P0 = MOD + 6144 + 2 * 1024; }
            else if (ph == 5 || ph == 12) { const int l = ph == 12; g = pg8::Gemm{Hb, (const bf16*)(ws + WS_W1) + (size_t)l * FF * D, 1024, 1024, 1024, 0}; Nc = FF; E.mode = 3; E.perm = true; }
            else { const int l = ph == 13; g = pg8::Gemm{A2, (const bf16*)(ws + WS_W2) + (size_t)l * FF * D, 4096, 4096, 4096, 0}; E.mode = 2; E.perm = false; E.P0 = MOD + l * 6144 + 5 * 1024; }
            pg8::StaticOrder S; S.init(Mr, Nc, F.G, bx);
            pg8::gemm_phase<EpiAll, pg8::StaticOrder, true, true>(F.lds + RING_OFF, g, S, E);
        }
        if (ph + 1 < hi) GRID_BAR();
    }
}

extern "C" void kernel_launch(void* const* d_in, const int* in_sizes, int n_in, void* d_out, int out_size, void* d_ws, size_t ws_size, hipStream_t stream) {
    static int grid = 0;
    if (grid == 0) {
        if (n_in != 20 || out_size != (int)OUT_END || ws_size < WS_END) { fprintf(stderr, "kernel_launch: unexpected shapes: n_in %d out %d ws %zu\n", n_in, out_size, ws_size); grid = -1; return; }
        int dev = 0, cus = 0, per_cu = 0;
        if (hipGetDevice(&dev) != hipSuccess || hipDeviceGetAttribute(&cus, hipDeviceAttributeMultiprocessorCount, dev) != hipSuccess) { grid = -1; return; }
        if (hipFuncSetAttribute((const void*)mk_fwd, hipFuncAttributeMaxDynamicSharedMemorySize, LDS_BYTES) != hipSuccess) { fprintf(stderr, "kernel_launch: hipFuncSetAttribute failed\n"); grid = -1; return; }
        if (hipOccupancyMaxActiveBlocksPerMultiprocessor(&per_cu, (const void*)mk_fwd, NWAVES * 64, LDS_BYTES) != hipSuccess || per_cu < 1) { fprintf(stderr, "kernel_launch: occupancy query says %d\n", per_cu); per_cu = 1; }
        (void)hipGetLastError();
        grid = cus;
    }
    if (grid < 0) return;
    (void)hipMemsetAsync((char*)d_ws + WS_CTL, 0, CTL_ZERO_BYTES, stream);
    Args a{};
    for (int i = 0; i < 20; ++i) a.in[i] = (const float*)d_in[i];
    a.out = (float*)d_out; a.ws = (unsigned char*)d_ws;
    if (N_LAUNCHES == 1) { a.ph_lo = 0; a.ph_hi = PER_PHASE; hipLaunchKernelGGL(mk_fwd, dim3(grid), dim3(NWAVES * 64), LDS_BYTES, stream, a); }
    else { for (int p = 0; p < PER_PHASE; ++p) { a.ph_lo = p; a.ph_hi = p + 1; hipLaunchKernelGGL(mk_fwd, dim3(grid), dim3(NWAVES * 64), LDS_BYTES, stream, a); } }
}
```

```cpp
#include <hip/hip_runtime.h>
#include <cstdio>
#include <cstdint>

#ifndef MK_N_LAUNCHES
#define MK_N_LAUNCHES 1
#endif

__device__ __forceinline__ int opaque_tid() { int t = threadIdx.x; asm volatile("" : "+v"(t)); return t; }

namespace pg8 {
#define PG8_LAS __attribute__((address_space(3)))
typedef unsigned short bf16_t;
typedef short bf16x8 __attribute__((ext_vector_type(8)));
typedef float f32x4 __attribute__((ext_vector_type(4)));
typedef unsigned u32x4 __attribute__((ext_vector_type(4)));
typedef unsigned u32x2 __attribute__((ext_vector_type(2)));
constexpr int BM = 256, BK = 64, HALF = 128, HTB = HALF * BK * 2  , STAGE_BYTES = 8 * HTB, NXCD = 8, WGM = 8;

__host__ __device__ __forceinline__ int lds_byte(int r, int c) { const int st = (r >> 4) * 2 + (c >> 5), rr = r & 15, cc = c & 31, ob = rr * 64 + cc * 2; return st * 1024 + (ob ^ (((ob >> 9) & 1) << 5)); }
__host__ __device__ __forceinline__ void stage_rc(int b, int& R, int& C) { const int st = b / 1024, sb = b % 1024, swz = sb ^ (((sb >> 9) & 1) << 5); R = (st >> 1) * 16 + swz / 64; C = (st & 1) * 32 + (swz % 64) / 2; }
__host__ __device__ __forceinline__ int perm32(int rho) { const int n = rho >> 4, i = rho & 15; return 8 * (i >> 2) + 4 * n + (i & 3); }

struct Unit { int pm, pn; };
struct Gemm { const bf16_t* A; const bf16_t* Bt; int K, lda, ldb, a_pn_off; };

struct StaticOrder {
    int nM, nN, nwg, G, c;
    __host__ __device__ void init(int M, int N, int G_, int c_) { nM = M / BM; nN = N / BM; nwg = nM * nN; G = G_; c = c_; }
    __host__ __device__ bool next(int i, Unit& u) const {
        const long L = (long)i * G + c; if (L >= nwg) return false;
        int wgid = (int)L; { const int q = nwg / NXCD, r = nwg % NXCD, xcd = wgid % NXCD, off = wgid / NXCD; wgid = (xcd < r ? xcd * (q + 1) : r * (q + 1) + (xcd - r) * q) + off; }
        const int nig = WGM * nN, gid = wgid / nig, fm = gid * WGM, gsz = (nM - fm) < WGM ? (nM - fm) : WGM;
        u.pm = fm + ((wgid % nig) % gsz); u.pn = (wgid % nig) / gsz; return true;
    }
    __device__ __forceinline__ void a_ready(const Unit&) const {}
    __device__ __forceinline__ void done(const Unit&) const {}
};

__device__ __forceinline__ unsigned cvt_pk_bf16(float lo, float hi) { unsigned r; asm volatile("v_cvt_pk_bf16_f32 %0, %1, %2" : "=v"(r) : "v"(lo), "v"(hi)); return r; }
typedef float f32x2 __attribute__((ext_vector_type(2)));
__device__ __forceinline__ f32x2 gelu_pk(f32x2 v) {
    const f32x2 av = __builtin_elementwise_abs(v), d = av * 0.2316418882f + 1.0f;
    f32x2 t; t.x = __builtin_amdgcn_rcpf(d.x); t.y = __builtin_amdgcn_rcpf(d.y);
    f32x2 q = t * 0.5307027145f + (-0.7265760135f); q = q * t + 0.7107068705f; q = q * t + (-0.142248368f); q = q * t + 0.127414796f; q = q * t;
    const f32x2 s = (v * v) * (-0.72134752044f);
    f32x2 e; e.x = __builtin_amdgcn_exp2f(s.x); e.y = __builtin_amdgcn_exp2f(s.y);
    const f32x2 m = v * (q * e), r = v - m;
    f32x2 o; o.x = v.x < 0.f ? m.x : r.x; o.y = v.y < 0.f ? m.y : r.y; return o;
}

template <class Epi, class Sched, bool ALIGN_EPI = false, bool SP2 = false>
__device__ __forceinline__ void gemm_phase(PG8_LAS unsigned char* lds, const Gemm g, const Sched& S, const Epi& E) {
    const int tid = opaque_tid(), wid = __builtin_amdgcn_readfirstlane(tid >> 6), lane = tid & 63, wr = wid >> 2, wc = wid & 3, fr = lane & 15, fq = lane >> 4;
    const int K = g.K, nt = K / BK;
    unsigned voffA[2], voffB[2];
#pragma unroll
    for (int i = 0; i < 2; ++i) { int R, C; stage_rc(tid * 16 + i * 8192, R, C); const int Rb = E.perm ? ((R & ~31) + perm32(R & 31)) : R;
        voffA[i] = (unsigned)(R * g.lda + C) * 2u; voffB[i] = (unsigned)(Rb * g.ldb + C) * 2u; }
    const size_t kstep = (size_t)(BK * 2);
    const size_t hstepA = (size_t)HALF * g.lda * 2, hstepB = (size_t)HALF * g.ldb * 2;
    const size_t tstepA = 2 * hstepA, tstepB = 2 * hstepB, pnoffA = (size_t)g.a_pn_off * 2;
    const unsigned ldsw = (unsigned)wid * 1024u;
    const int aoff = lds_byte(wr * 64 + fr, fq * 8), boff = lds_byte(wc * 32 + fr, fq * 8);
#define PG8_SA(b, h) (((b) * 2 + (h)) * HTB)
#define PG8_SB(b, h) ((4 + (b) * 2 + (h)) * HTB)
#define PG8_STAGE(bufoff, gbase, voff) do { _Pragma("unroll") for (int _i = 0; _i < 2; ++_i) \
        __builtin_amdgcn_global_load_lds((const unsigned*)((const char*)(gbase) + (voff)[_i]), (PG8_LAS unsigned*)(lds + (bufoff) + ldsw + _i * 8192), 16, 0, 0); } while (0)
#define PG8_LDA(dst, b, h) do { _Pragma("unroll") for (int m = 0; m < 4; ++m) _Pragma("unroll") for (int k = 0; k < 2; ++k) dst[m][k] = *(const PG8_LAS bf16x8*)(lds + PG8_SA(b, h) + aoff + m * 2048 + k * 1024); } while (0)
#define PG8_LDB(dst, b, h) do { _Pragma("unroll") for (int n = 0; n < 2; ++n) _Pragma("unroll") for (int k = 0; k < 2; ++k) dst[n][k] = *(const PG8_LAS bf16x8*)(lds + PG8_SB(b, h) + boff + n * 2048 + k * 1024); } while (0)
#define PG8_MMA(ai, bj, At, Bt) do { __builtin_amdgcn_s_setprio(1); _Pragma("unroll") for (int m = 0; m < 4; ++m) _Pragma("unroll") for (int n = 0; n < 2; ++n) _Pragma("unroll") for (int k = 0; k < 2; ++k) \
        acc[ai][bj][m][n] = __builtin_amdgcn_mfma_f32_16x16x32_bf16(Bt[n][k], At[m][k], acc[ai][bj][m][n], 0, 0, 0); __builtin_amdgcn_s_setprio(0); } while (0)
#define PG8_WAIT_V(n) asm volatile("s_waitcnt vmcnt(" #n ")" ::: "memory")
#define PG8_WAIT_L(n) asm volatile("s_waitcnt lgkmcnt(" #n ")" ::: "memory")
#define PG8_BAR __builtin_amdgcn_s_barrier()
#define PG8_SCHED __builtin_amdgcn_sched_barrier(0)
    Unit cur, nxt; int ui = 0;
    if (!S.next(0, cur)) return;
    f32x4 acc[2][2][4][2];
#pragma unroll
    for (int a = 0; a < 2; ++a)
#pragma unroll
        for (int b = 0; b < 2; ++b)
#pragma unroll
            for (int m = 0; m < 4; ++m)
#pragma unroll
                for (int n = 0; n < 2; ++n) acc[a][b][m][n] = (f32x4){0.f, 0.f, 0.f, 0.f};
    bf16x8 At[4][2], B0[2][2], B1[2][2];
    const char* cA = (const char*)g.A + (size_t)cur.pm * tstepA + (size_t)cur.pn * pnoffA; const char* cB = (const char*)g.Bt + (size_t)cur.pn * tstepB;
    S.a_ready(cur);
    if constexpr (SP2) {
        PG8_STAGE(PG8_SB(0, 0), cB, voffB); PG8_STAGE(PG8_SB(0, 1), cB + hstepB, voffB); PG8_STAGE(PG8_SA(0, 0), cA, voffA); PG8_STAGE(PG8_SA(0, 1), cA + hstepA, voffA);
        if (wr == 1) PG8_BAR;
        PG8_WAIT_V(2); PG8_BAR;
        PG8_STAGE(PG8_SB(1, 0), cB + kstep, voffB); PG8_STAGE(PG8_SA(1, 0), cA + kstep, voffA); PG8_STAGE(PG8_SB(1, 1), cB + hstepB + kstep, voffB);
        PG8_WAIT_V(6); PG8_BAR;
    } else {
        PG8_STAGE(PG8_SB(0, 0), cB, voffB); PG8_STAGE(PG8_SA(0, 0), cA, voffA); PG8_STAGE(PG8_SB(0, 1), cB + hstepB, voffB); PG8_STAGE(PG8_SA(0, 1), cA + hstepA, voffA);
        if (wr == 1) PG8_BAR;
        PG8_WAIT_V(4); PG8_BAR;
        PG8_STAGE(PG8_SB(1, 0), cB + kstep, voffB); PG8_STAGE(PG8_SA(1, 0), cA + kstep, voffA); PG8_STAGE(PG8_SB(1, 1), cB + hstepB + kstep, voffB);
        PG8_WAIT_V(6); PG8_BAR;
    }
    for (;;) {
        const bool has_next = S.next(ui + 1, nxt);
        const char* nA = has_next ? (const char*)g.A + (size_t)nxt.pm * tstepA + (size_t)nxt.pn * pnoffA : cA; const char* nB = has_next ? (const char*)g.Bt + (size_t)nxt.pn * tstepB : cB;
        for (int t = 0; t < nt; t += 2) {
            const bool last = (t == nt - 2);
            const char* a1 = cA + (size_t)(t + 1) * kstep;
            const char* a2 = last ? nA : cA + (size_t)(t + 2) * kstep; const char* b2 = last ? nB : cB + (size_t)(t + 2) * kstep;
            const char* a3 = a2 + kstep; const char* b3 = b2 + kstep;
            if (last && has_next) S.a_ready(nxt);
            if constexpr (SP2) {
            PG8_LDB(B0, 0, 0); PG8_LDB(B1, 0, 1); PG8_SCHED; PG8_LDA(At, 0, 0); PG8_STAGE(PG8_SA(1, 1), a1 + hstepA, voffA);
            PG8_WAIT_V(8); PG8_WAIT_L(0); PG8_BAR; PG8_MMA(0, 0, At, B0); PG8_MMA(0, 1, At, B1); PG8_BAR; PG8_SCHED;
            PG8_LDA(At, 0, 1); PG8_STAGE(PG8_SB(0, 0), b2, voffB); PG8_STAGE(PG8_SB(0, 1), b2 + hstepB, voffB); PG8_STAGE(PG8_SA(0, 0), a2, voffA);
            PG8_WAIT_V(8); PG8_WAIT_L(0); PG8_BAR; PG8_MMA(1, 0, At, B0); PG8_MMA(1, 1, At, B1); PG8_BAR; PG8_SCHED;
            PG8_LDB(B0, 1, 0); PG8_LDB(B1, 1, 1); PG8_SCHED; PG8_LDA(At, 1, 0); PG8_STAGE(PG8_SA(0, 1), a2 + hstepA, voffA);
            PG8_WAIT_V(8); PG8_WAIT_L(0); PG8_BAR; PG8_MMA(0, 0, At, B0); PG8_MMA(0, 1, At, B1); PG8_BAR; PG8_SCHED;
            PG8_LDA(At, 1, 1); PG8_STAGE(PG8_SB(1, 0), b3, voffB); PG8_STAGE(PG8_SB(1, 1), b3 + hstepB, voffB); PG8_STAGE(PG8_SA(1, 0), a3, voffA);
            PG8_WAIT_V(8); PG8_WAIT_L(0); PG8_BAR; PG8_MMA(1, 0, At, B0); PG8_MMA(1, 1, At, B1); PG8_BAR; PG8_SCHED;
            } else {
            PG8_LDB(B0, 0, 0); PG8_SCHED; PG8_LDA(At, 0, 0); PG8_STAGE(PG8_SA(1, 1), a1 + hstepA, voffA);
            PG8_WAIT_L(8); PG8_BAR; PG8_WAIT_L(0); PG8_MMA(0, 0, At, B0); PG8_BAR; PG8_SCHED;
            PG8_LDB(B1, 0, 1); PG8_STAGE(PG8_SB(0, 0), b2, voffB);
            PG8_BAR; PG8_WAIT_L(0); PG8_MMA(0, 1, At, B1); PG8_BAR;
            PG8_LDA(At, 0, 1); PG8_STAGE(PG8_SA(0, 0), a2, voffA);
            PG8_BAR; PG8_WAIT_L(0); PG8_MMA(1, 0, At, B0); PG8_BAR; PG8_SCHED;
            PG8_STAGE(PG8_SB(0, 1), b2 + hstepB, voffB);
            PG8_WAIT_V(6); PG8_BAR; PG8_MMA(1, 1, At, B1); PG8_BAR;
            PG8_LDB(B0, 1, 0); PG8_SCHED; PG8_LDA(At, 1, 0); PG8_STAGE(PG8_SA(0, 1), a2 + hstepA, voffA);
            PG8_WAIT_L(8); PG8_BAR; PG8_WAIT_L(0); PG8_MMA(0, 0, At, B0); PG8_BAR; PG8_SCHED;
            PG8_LDB(B1, 1, 1); PG8_STAGE(PG8_SB(1, 0), b3, voffB);
            PG8_BAR; PG8_WAIT_L(0); PG8_MMA(0, 1, At, B1); PG8_BAR;
            PG8_LDA(At, 1, 1); PG8_STAGE(PG8_SA(1, 0), a3, voffA);
            PG8_BAR; PG8_WAIT_L(0); PG8_MMA(1, 0, At, B0); PG8_BAR; PG8_SCHED;
            PG8_STAGE(PG8_SB(1, 1), b3 + hstepB, voffB);
            PG8_WAIT_V(6); PG8_BAR; PG8_MMA(1, 1, At, B1); PG8_BAR;
            }
        }
        if constexpr (ALIGN_EPI) { if (wr == 0) PG8_BAR; }
        E(acc, cur, wr, wc, fr, fq); S.done(cur);
        if (!has_next) break;
#pragma unroll
        for (int a = 0; a < 2; ++a)
#pragma unroll
            for (int b = 0; b < 2; ++b)
#pragma unroll
                for (int m = 0; m < 4; ++m)
#pragma unroll
                    for (int n = 0; n < 2; ++n) acc[a][b][m][n] = (f32x4){0.f, 0.f, 0.f, 0.f};
        cur = nxt; cA = nA; cB = nB; ++ui;
        if constexpr (ALIGN_EPI) { if (wr == 1) PG8_BAR; }
    }
    PG8_WAIT_V(0);
    if constexpr (!ALIGN_EPI) { if (wr == 0) PG8_BAR; }
    PG8_BAR;
#undef PG8_SA
#undef PG8_SB
#undef PG8_STAGE
#undef PG8_LDA
#undef PG8_LDB
#undef PG8_MMA
#undef PG8_WAIT_V
#undef PG8_WAIT_L
#undef PG8_BAR
#undef PG8_SCHED
}
}

constexpr int NWAVES = 8;
constexpr int N_LAUNCHES = MK_N_LAUNCHES;
constexpr int PER_PHASE = 15;
constexpr int D = 1024, FF = 4096, NP = 16384, NS = 1024, M = NP + NS, NSEQ = 136, SEQ = 2048, DSEQ = 8;
constexpr int MODW = 12288;
constexpr float EPS = 1e-6f;

constexpr size_t OUT_Y = 0, OUT_PP = (size_t)M * D, OUT_PS = OUT_PP + 8 * 15 * 1024, OUT_VP = OUT_PS + 128 * 15 * 1024, OUT_VS = OUT_VP + 8 * 128 * 1024, OUT_END = OUT_VS + 128 * 8 * 1024;

constexpr size_t MiB = 1u << 20;
constexpr size_t WS_CTL = 0, CTL_ZERO_BYTES = 1 * MiB;
constexpr size_t WS_VSTAT = 512 * 1024;
constexpr size_t WS_MOD = 1 * MiB;
constexpr size_t WS_RSTD0 = 14 * MiB;
constexpr size_t WS_SC = 15 * MiB;
constexpr size_t WS_WP = 16 * MiB;
constexpr size_t WS_WSP = 17 * MiB;
constexpr size_t WS_WOUT = 18 * MiB;
constexpr size_t WS_WIN = 20 * MiB;
constexpr size_t WS_W1 = 24 * MiB;
constexpr size_t WS_W2 = 40 * MiB;
constexpr size_t WS_H = 56 * MiB;
constexpr size_t WS_A2 = 90 * MiB;
constexpr size_t WS_WADA = WS_A2;
constexpr size_t WS_U = WS_A2, WS_V = WS_A2 + 34 * MiB, WS_G = WS_A2 + 68 * MiB;
constexpr size_t WS_END = 226 * MiB;
constexpr int CW_TMO = 0, CW_BAR = 4096;

constexpr int RING_OFF = 0, RING_BYTES = 131072;
constexpr int LDSCTL_OFF = RING_BYTES, MISC_OFF = LDSCTL_OFF + 320;
constexpr int LDS_BYTES = 147456;

#define GAS __attribute__((address_space(1)))
#define LAS __attribute__((address_space(3)))
typedef unsigned short bf16;
typedef unsigned v4u __attribute__((ext_vector_type(4)));
typedef unsigned v2u __attribute__((ext_vector_type(2)));
typedef float f32x4 __attribute__((ext_vector_type(4)));
typedef float f32x16 __attribute__((ext_vector_type(16)));
typedef short bf16x8 __attribute__((ext_vector_type(8)));
typedef GAS unsigned gu32;
#define RLX_AGENT __ATOMIC_RELAXED, __HIP_MEMORY_SCOPE_AGENT
#define LDS_WAIT() asm volatile("s_waitcnt lgkmcnt(0)" ::: "memory")
#define VM_WAIT() asm volatile("s_waitcnt vmcnt(0)" ::: "memory")
__device__ __forceinline__ unsigned f2bf(float f) { unsigned u = __builtin_bit_cast(unsigned, f); return (u + 0x7fffu + ((u >> 16) & 1u)) >> 16; }
__device__ __forceinline__ unsigned pk2(float lo, float hi) { return f2bf(lo) | (f2bf(hi) << 16); }
__device__ __forceinline__ float bf2f(unsigned short b) { return __builtin_bit_cast(float, (unsigned)b << 16); }
__device__ __forceinline__ int seq_of_row(int row) { return row < NP ? (row >> 11) : (8 + ((row - NP) >> 3)); }

#define XB_TMO      128
#define XB_XCNT(j)  (256  + 64 * (j))
#define XB_XSUB(j)  (1280 + 64 * (j))
#define XB_XGEN(j)  (2304 + 64 * (j))
#define XB_TOP      3328
#define XB_TOPGEN   3392
#define XCD_BAR_WORDS 3456
#define XB_SPIN_CAP (1u << 18)
__device__ __forceinline__ unsigned xb_ld(unsigned* p)              { return __hip_atomic_load(p, __ATOMIC_RELAXED, __HIP_MEMORY_SCOPE_AGENT); }
__device__ __forceinline__ unsigned xb_add(unsigned* p, unsigned v) { return __hip_atomic_fetch_add(p, v, __ATOMIC_RELAXED, __HIP_MEMORY_SCOPE_AGENT); }
__device__ __forceinline__ unsigned xb_xcc_id() { return (unsigned)__builtin_amdgcn_s_getreg((3 << 11) | 20) & 0xFu; }
#define XB_SPIN(cond, bar) do { unsigned _sp = 0; while (cond) { __builtin_amdgcn_s_sleep(1); \
    if ((++_sp & 255u) == 0u) { if (xb_ld(&(bar)[XB_TMO])) break; if (_sp > XB_SPIN_CAP) { atomicAdd(&(bar)[XB_TMO], 1u); break; } } } } while (0)
struct XcdBarrier { unsigned* bar; unsigned x; volatile LAS unsigned* st; };
__device__ __forceinline__ XcdBarrier xcd_barrier_post(unsigned* bar, volatile LAS unsigned* st) {
    XcdBarrier b; b.bar = bar; b.x = xb_xcc_id(); b.st = st;
    if (threadIdx.x == 0) (void)xb_add(&bar[XB_XCNT(b.x)], 1u);
    return b;
}
__device__ __forceinline__ void xcd_barrier_complete(unsigned* bar, unsigned x, unsigned& nloc, unsigned& nx) {
    const unsigned G = gridDim.x * gridDim.y * gridDim.z;
    unsigned sum, cnt, mine, sp = 0u;
    for (;;) {
        sum = 0u; cnt = 0u; mine = 0u;
#pragma unroll
        for (unsigned j = 0; j < 16; ++j) { const unsigned c = xb_ld(&bar[XB_XCNT(j)]); sum += c; cnt += (c > 0u) ? 1u : 0u; mine = (j == x) ? c : mine; }
        if (sum == G) break;
        __builtin_amdgcn_s_sleep(1);
        if ((++sp & 255u) == 0u) { if (xb_ld(&bar[XB_TMO])) break; if (sp > XB_SPIN_CAP) { atomicAdd(&bar[XB_TMO], 1u); break; } }
    }
    nloc = mine > 0u ? mine : 1u; nx = cnt > 0u ? cnt : 1u;
}
__device__ __forceinline__ void xcd_barrier(const XcdBarrier& b) {
    asm volatile("s_waitcnt vmcnt(0)" ::: "memory");
    __syncthreads();
    if (threadIdx.x == 0) {
        unsigned* bar = b.bar;
        __builtin_amdgcn_s_waitcnt(0);
        unsigned nloc = b.st[0], nx = b.st[1];
        if (nloc == 0u) { xcd_barrier_complete(bar, b.x, nloc, nx); b.st[0] = nloc; b.st[1] = nx; }
        const unsigned old = xb_add(&bar[XB_XSUB(b.x)], 1u);
        const unsigned gen = old / nloc;
        if (old + 1u == (gen + 1u) * nloc) {
            __builtin_amdgcn_fence(__ATOMIC_RELEASE, "agent");
            asm volatile("s_waitcnt vmcnt(0)" ::: "memory");
            const unsigned og = xb_add(&bar[XB_TOP], 1u);
            const unsigned tg = og / nx;
            if (og + 1u == (tg + 1u) * nx) xb_add(&bar[XB_TOPGEN], 1u);
            else XB_SPIN(xb_ld(&bar[XB_TOPGEN]) == tg, bar);
            __builtin_amdgcn_fence(__ATOMIC_ACQUIRE, "agent");
            xb_add(&bar[XB_XGEN(b.x)], 1u);
            asm volatile("s_waitcnt vmcnt(0)" ::: "memory");
        } else {
            XB_SPIN(xb_ld(&bar[XB_XGEN(b.x)]) == gen, bar);
            __builtin_amdgcn_fence(__ATOMIC_ACQUIRE, "agent");
            asm volatile("s_waitcnt vmcnt(0)" ::: "memory");
        }
    }
    __syncthreads();
}

using pg8::Unit; using pg8::HALF; using pg8::BM;
struct EpiAll {
    int mode; bool perm;
    float* F0; const float* P0; const float* P1; const float* P2; const float* P3; bf16* B0; bf16* B1;
    __device__ __forceinline__ void operator()(const f32x4 (&acc)[2][2][4][2], const Unit& u, int wr, int wc, int fr, int fq) const {
        const int row0 = u.pm * BM + wr * 64 + fr;
        if (mode == 0) {
            const int col0 = u.pn * BM + wc * 32 + 4 * fq;
            f32x4 bv[2][2];
#pragma unroll
            for (int bj = 0; bj < 2; ++bj)
#pragma unroll
                for (int n = 0; n < 2; ++n) bv[bj][n] = *(const f32x4*)(P0 + col0 + bj * HALF + n * 16);
#pragma unroll
            for (int ai = 0; ai < 2; ++ai)
#pragma unroll
                for (int m = 0; m < 4; ++m) { float* rowp = F0 + (size_t)(row0 + ai * HALF + m * 16) * MODW + col0;
#pragma unroll
                    for (int bj = 0; bj < 2; ++bj)
#pragma unroll
                        for (int n = 0; n < 2; ++n) *(f32x4*)(rowp + bj * HALF + n * 16) = acc[ai][bj][m][n] + bv[bj][n]; }
        } else if (mode == 1) {
            const int col0 = u.pn * BM + wc * 32 + 4 * fq;
            f32x4 ps[2][2];
#pragma unroll
            for (int bj = 0; bj < 2; ++bj)
#pragma unroll
                for (int n = 0; n < 2; ++n) ps[bj][n] = *(const f32x4*)(P1 + col0 + bj * HALF + n * 16);
#pragma unroll
            for (int ai = 0; ai < 2; ++ai)
#pragma unroll
                for (int m = 0; m < 4; ++m) { const int row = row0 + ai * HALF + m * 16; const int seq = seq_of_row(row);
                    const float* xr = (row < NP ? P2 + (size_t)row * D : P3 + (size_t)(row - NP) * D) + col0; const float* gr = P0 + (size_t)seq * MODW + col0; float* orow = F0 + (size_t)row * D + col0;
#pragma unroll
                    for (int bj = 0; bj < 2; ++bj)
#pragma unroll
                        for (int n = 0; n < 2; ++n) { const int o = bj * HALF + n * 16; const f32x4 xv = *(const f32x4*)(xr + o), gv = *(const f32x4*)(gr + o);
                            *(f32x4*)(orow + o) = xv + gv * ps[bj][n] * acc[ai][bj][m][n]; } }
        } else if (mode == 2) {
            const int col0 = u.pn * BM + wc * 32 + 4 * fq;
#pragma unroll
            for (int ai = 0; ai < 2; ++ai)
#pragma unroll
                for (int m = 0; m < 4; ++m) { const int row = row0 + ai * HALF + m * 16; const int seq = seq_of_row(row);
                    const float* gr = P0 + (size_t)seq * MODW + col0; float* orow = F0 + (size_t)row * D + col0;
#pragma unroll
                    for (int bj = 0; bj < 2; ++bj)
#pragma unroll
                        for (int n = 0; n < 2; ++n) { const int o = bj * HALF + n * 16; const f32x4 xv = *(const f32x4*)(orow + o), gv = *(const f32x4*)(gr + o);
                            *(f32x4*)(orow + o) = xv + gv * acc[ai][bj][m][n]; } }
        } else if (mode == 3) {
            const int col0 = u.pn * BM + wc * 32 + 8 * fq;
#pragma unroll
            for (int ai = 0; ai < 2; ++ai)
#pragma unroll
                for (int m = 0; m < 4; ++m) { bf16* rowp = B0 + (size_t)(row0 + ai * HALF + m * 16) * FF + col0;
#pragma unroll
                    for (int bj = 0; bj < 2; ++bj) { f32x4 v0 = acc[ai][bj][m][0], v1 = acc[ai][bj][m][1];
#pragma unroll
                        for (int j = 0; j < 4; ++j) { const float a = fmaxf(v0[j], 0.f), b = fmaxf(v1[j], 0.f); v0[j] = a * a; v1[j] = b * b; }
                        v4u w; w.x = pg8::cvt_pk_bf16(v0[0], v0[1]); w.y = pg8::cvt_pk_bf16(v0[2], v0[3]); w.z = pg8::cvt_pk_bf16(v1[0], v1[1]); w.w = pg8::cvt_pk_bf16(v1[2], v1[3]);
                        *(v4u*)(rowp + bj * HALF) = w; } }
        } else {
            const bool isv = u.pn >= 4;
            const int colt = (u.pn & 3) * BM, col0 = colt + wc * 32 + 8 * fq, bcol0 = u.pn * BM + wc * 32 + 8 * fq;
            bf16* base = isv ? B1 : B0;
            f32x4 bv[2][2];
#pragma unroll
            for (int bj = 0; bj < 2; ++bj)
#pragma unroll
                for (int n = 0; n < 2; ++n) bv[bj][n] = *(const f32x4*)(P0 + bcol0 + bj * HALF + 4 * n);
#pragma unroll
            for (int ai = 0; ai < 2; ++ai)
#pragma unroll
                for (int m = 0; m < 4; ++m) { const int row = row0 + ai * HALF + m * 16; bf16* rowp = base + (size_t)row * D + col0; float s = 0.f, q = 0.f;
#pragma unroll
                    for (int bj = 0; bj < 2; ++bj) { f32x4 v0 = acc[ai][bj][m][0] + bv[bj][0], v1 = acc[ai][bj][m][1] + bv[bj][1];
                        pg8::f32x2 a = pg8::gelu_pk((pg8::f32x2){v0[0], v0[1]}), b = pg8::gelu_pk((pg8::f32x2){v0[2], v0[3]}), c = pg8::gelu_pk((pg8::f32x2){v1[0], v1[1]}), d = pg8::gelu_pk((pg8::f32x2){v1[2], v1[3]});
                        s += (a.x + a.y) + (b.x + b.y) + (c.x + c.y) + (d.x + d.y);
                        q += (a.x * a.x + a.y * a.y) + (b.x * b.x + b.y * b.y) + (c.x * c.x + c.y * c.y) + (d.x * d.x + d.y * d.y);
                        v4u w; w.x = pg8::cvt_pk_bf16(a.x, a.y); w.y = pg8::cvt_pk_bf16(b.x, b.y); w.z = pg8::cvt_pk_bf16(c.x, c.y); w.w = pg8::cvt_pk_bf16(d.x, d.y);
                        *(v4u*)(rowp + bj * HALF) = w; }
                    if (isv) { s += __shfl_xor(s, 16); s += __shfl_xor(s, 32); q += __shfl_xor(q, 16); q += __shfl_xor(q, 32);
                        if (fq == 0) { atomicAdd(F0 + 2 * (size_t)row, s); atomicAdd(F0 + 2 * (size_t)row + 1, q); } } }
        }
    }
};

struct Frame {
    LAS unsigned char* lds;
    volatile LAS unsigned* MISC;
    gu32* ctl;
    int tid, lane, wave;
    int vcu, G;
};
struct Args { const float* in[20]; float* out; unsigned char* ws; int ph_lo, ph_hi; };
__device__ __forceinline__ void frame_refresh(Frame& F) { F.tid = opaque_tid(); F.lane = F.tid & 63; F.wave = __builtin_amdgcn_readfirstlane(F.tid >> 6); }

__device__ __forceinline__ float wave_sum(float v) {
#pragma unroll
    for (int o = 1; o < 64; o <<= 1) v += __shfl_xor(v, o);
    return v;
}
__device__ __forceinline__ void p0_transpose_item(const float* W, int K, int N, bf16* WT, int row_off, LAS float* scr, int item, int lane) {
    const int nblk = N / 32, kb = item / nblk, nb = item % nblk, k0 = 64 * kb, n0 = 32 * nb;
#pragma unroll 8
    for (int i = 0; i < 32; ++i) { const int kk = 2 * i + (lane >> 5); scr[kk * 33 + (lane & 31)] = W[(size_t)(k0 + kk) * N + n0 + (lane & 31)]; }
    LDS_WAIT(); asm volatile("" ::: "memory");
    const int c = lane & 7;
#pragma unroll
    for (int j = 0; j < 4; ++j) { const int n = (lane >> 3) + 8 * j; const LAS float* s = scr + (8 * c) * 33 + n;
        v4u o; o.x = pk2(s[0 * 33], s[1 * 33]); o.y = pk2(s[2 * 33], s[3 * 33]); o.z = pk2(s[4 * 33], s[5 * 33]); o.w = pk2(s[6 * 33], s[7 * 33]);
        *(GAS v4u*)(WT + (size_t)(row_off + n0 + n) * K + k0 + 8 * c) = o; }
    LDS_WAIT(); asm volatile("" ::: "memory");
}

__device__ __forceinline__ void p0_prologue(Frame& F, const Args& a) {
    frame_refresh(F);
    unsigned char* ws = a.ws;
    LAS float* scr = (LAS float*)(F.lds + RING_OFF + F.wave * 16384);
    const int gw = F.vcu * NWAVES + F.wave, NGW = F.G * NWAVES;
    constexpr int I_ADA = 16 * 192, I_POOL = 4 * 8, I_IN = 16 * 64, I_OUT = 16 * 32, I_W1 = 16 * 128, I_W2 = 64 * 32;
    constexpr int NITEMS = 2 * I_ADA + 4 * I_POOL + I_IN + I_OUT + 2 * I_W1 + 2 * I_W2;
    for (int it = gw; it < NITEMS; it += NGW) {
        int r = it;
        if (r < 2 * I_ADA) { const int l = r / I_ADA; p0_transpose_item(a.in[6] + (size_t)l * 1024 * 6144, 1024, 6144, (bf16*)(ws + WS_WADA), l * 6144, scr, r % I_ADA, F.lane); continue; } r -= 2 * I_ADA;
        if (r < 4 * I_POOL) { const int g = r / I_POOL; p0_transpose_item(a.in[8] + (size_t)g * 65536, 256, 256, (bf16*)(ws + WS_WP), g * 256, scr, r % I_POOL, F.lane); continue; } r -= 4 * I_POOL;
        if (r < I_IN) { p0_transpose_item(a.in[10], 1024, 2048, (bf16*)(ws + WS_WIN), 0, scr, r, F.lane); continue; } r -= I_IN;
        if (r < I_OUT) { p0_transpose_item(a.in[16], 1024, 1024, (bf16*)(ws + WS_WOUT), 0, scr, r, F.lane); continue; } r -= I_OUT;
        if (r < 2 * I_W1) { const int l = r / I_W1; p0_transpose_item(a.in[17] + (size_t)l * 1024 * 4096, 1024, 4096, (bf16*)(ws + WS_W1) + (size_t)l * 4096 * 1024, 0, scr, r % I_W1, F.lane); continue; } r -= 2 * I_W1;
        { const int l = r / I_W2; p0_transpose_item(a.in[18] + (size_t)l * 4096 * 1024, 4096, 1024, (bf16*)(ws + WS_W2) + (size_t)l * 4096 * 1024, 0, scr, r % I_W2, F.lane); }
    }
    {
        const float* wsp = a.in[14]; bf16* o = (bf16*)(ws + WS_WSP);
        for (int i = (F.vcu * NWAVES + F.wave) * 64 + F.lane; i < 2 * 65536; i += NGW * 64) {
            const int var = i >> 16, e = i & 65535, g = e >> 14, t = (e >> 7) & 127, s = e & 127;
            float v = 0.f;
            if (var == 0) { if (s <= t) v = wsp[(size_t)g * 16384 + t * 128 + s]; }
            else { if ((t >> 3) == (s >> 3) && (s & 7) <= (t & 7)) v = wsp[(size_t)g * 16384 + (t & 7) * 128 + (s & 7)]; }
            o[i] = (bf16)f2bf(v);
        }
    }
    float* rstd0 = (float*)(ws + WS_RSTD0);
    for (int m = gw; m < M; m += NGW) {
        const float* xrow = m < NP ? a.in[0] + (size_t)m * D : a.in[1] + (size_t)(m - NP) * D;
        const GAS f32x4* xr = (const GAS f32x4*)xrow + F.lane; float s = 0.f;
#pragma unroll
        for (int j = 0; j < 4; ++j) { const f32x4 v = xr[64 * j]; s += (v.x * v.x + v.y * v.y) + (v.z * v.z + v.w * v.w); }
        s = wave_sum(s);
        if (F.lane == 0) rstd0[m] = 1.0f / sqrtf(s * (1.0f / D) + EPS);
    }
    bf16* sc = (bf16*)(ws + WS_SC);
    for (int m = gw; m < 256; m += NGW) {
        GAS unsigned long long* o8 = (GAS unsigned long long*)(sc + (size_t)m * D) + F.lane;
        if (m < NSEQ) {
            const float* crow = m < 8 ? a.in[2] + (size_t)m * D : a.in[3] + (size_t)(m - 8) * D;
            const GAS f32x4* cr = (const GAS f32x4*)crow + F.lane;
#pragma unroll
            for (int j = 0; j < 4; ++j) { f32x4 v = cr[64 * j];
#pragma unroll
                for (int e = 0; e < 4; ++e) v[e] = v[e] / (1.0f + __expf(-v[e]));
                o8[64 * j] = (unsigned long long)pk2(v.x, v.y) | ((unsigned long long)pk2(v.z, v.w) << 32); }
        } else {
#pragma unroll
            for (int j = 0; j < 4; ++j) o8[64 * j] = 0ull;
        }
    }
}

__device__ __forceinline__ void pool_prepass(Frame& F, const Args& a) {
    frame_refresh(F);
    unsigned char* ws = a.ws;
    const float* rstd0 = (const float*)(ws + WS_RSTD0); const float* MOD = (const float*)(ws + WS_MOD);
    const float* ng = a.in[5];
    bf16* Dm = (bf16*)(ws + WS_H);
    LAS float* hb = (LAS float*)(F.lds + RING_OFF);
    for (int u = F.vcu; u < NP / 64; u += F.G) {
        const int b = u >> 5, t0 = (u & 31) * 64, seq = b; const bool lastu = (t0 == SEQ - 64);
        const float* sh = MOD + (size_t)seq * MODW + 0 * 1024; const float* scp = MOD + (size_t)seq * MODW + 1 * 1024;
        for (int g = 0; g < 4; ++g) {
            const int w = 2 << g, c4 = 256 * g + 4 * F.lane;
            const f32x4 gv = *(const f32x4*)(ng + c4), sv = *(const f32x4*)(scp + c4), hv = *(const f32x4*)(sh + c4);
            const f32x4 gm = gv * (sv + 1.0f);
            for (int j = F.wave; j < 79; j += NWAVES) {
                const int t = t0 - 15 + j; f32x4 h = (f32x4){0.f, 0.f, 0.f, 0.f};
                if (t >= 0) { const int row = b * SEQ + t; const f32x4 xv = *(const f32x4*)(a.in[0] + (size_t)row * D + c4); h = xv * rstd0[row] * gm + hv;
                    if (lastu && j >= 64) *(f32x4*)(a.out + OUT_PP + ((size_t)b * 15 + (j - 64)) * D + c4) = h; }
                *(LAS f32x4*)(hb + j * 256 + 4 * F.lane) = h;
            }
            __syncthreads();
            {
                const int col = F.tid & 255, half = F.tid >> 8; float s = 0.f;
                const int j0 = half * 32 + 15;
                for (int q = 1; q < w; ++q) s += hb[(j0 - q) * 256 + col];
                for (int i = 0; i < 32; ++i) { const int j = j0 + i, t = t0 + half * 32 + i; const float cur = hb[j * 256 + col]; s += cur;
                    const int cnt = (t + 1) < w ? (t + 1) : w; const float d = s / (float)cnt - cur; s -= hb[(j - w + 1) * 256 + col];
                    Dm[(size_t)(b * SEQ + t) * D + 256 * g + col] = (bf16)f2bf(d); }
            }
            __syncthreads();
        }
    }
    for (int s_ = F.vcu; s_ < 128; s_ += F.G) {
        const int seq = 8 + s_;
        const float* sh = MOD + (size_t)seq * MODW + 0 * 1024; const float* scp = MOD + (size_t)seq * MODW + 1 * 1024;
        for (int j = F.wave; j < 23; j += NWAVES) {
#pragma unroll
            for (int q = 0; q < 4; ++q) { const int c4 = 256 * q + 4 * F.lane; f32x4 h;
                if (j < 15) h = *(const f32x4*)(a.in[4] + ((size_t)s_ * 15 + j) * D + c4);
                else { const int row = NP + s_ * 8 + (j - 15); const f32x4 xv = *(const f32x4*)(a.in[1] + (size_t)(row - NP) * D + c4);
                    const f32x4 gv = *(const f32x4*)(ng + c4), sv = *(const f32x4*)(scp + c4), hv = *(const f32x4*)(sh + c4); h = xv * rstd0[row] * (gv * (sv + 1.0f)) + hv; }
                if (j >= 8) *(f32x4*)(a.out + OUT_PS + ((size_t)s_ * 15 + (j - 8)) * D + c4) = h;
                *(LAS f32x4*)(hb + j * 1024 + c4) = h; }
        }
        __syncthreads();
        for (int col = F.tid; col < 1024; col += NWAVES * 64) { const int w = 2 << (col >> 8);
            for (int t = 0; t < 8; ++t) { const int j = 15 + t; float s = 0.f;
                for (int q = 0; q < w; ++q) s += hb[(j - q) * 1024 + col];
                const float d = s / (float)w - hb[j * 1024 + col];
                Dm[(size_t)(NP + s_ * 8 + t) * D + col] = (bf16)f2bf(d); } }
        __syncthreads();
    }
}

__device__ __forceinline__ void norm_rows(Frame& F, const float* X, const float* g, const float* sh_base, const float* sc_base, bf16* H) {
    frame_refresh(F);
    const int gw = F.vcu * NWAVES + F.wave, NGW = F.G * NWAVES;
    for (int m = gw; m < M; m += NGW) {
        const int seq = seq_of_row(m);
        const GAS f32x4* xr = (const GAS f32x4*)(X + (size_t)m * D) + F.lane; f32x4 v[4]; float s = 0.f;
#pragma unroll
        for (int j = 0; j < 4; ++j) { v[j] = xr[64 * j]; s += (v[j].x * v[j].x + v[j].y * v[j].y) + (v[j].z * v[j].z + v[j].w * v[j].w); }
        const float rstd = 1.0f / sqrtf(wave_sum(s) * (1.0f / D) + EPS);
        GAS unsigned long long* o8 = (GAS unsigned long long*)(H + (size_t)m * D) + F.lane;
#pragma unroll
        for (int j = 0; j < 4; ++j) { const int c4 = 4 * F.lane + 256 * j;
            const f32x4 gv = *(const f32x4*)(g + c4), sv = *(const f32x4*)(sc_base + (size_t)seq * MODW + c4), hv = *(const f32x4*)(sh_base + (size_t)seq * MODW + c4);
            const f32x4 h = v[j] * rstd * gv * (sv + 1.0f) + hv;
            o8[64 * j] = (unsigned long long)pk2(h.x, h.y) | ((unsigned long long)pk2(h.z, h.w) << 32); }
    }
}
__device__ __forceinline__ void final_norm(Frame& F, float* X, const float* g) {
    frame_refresh(F);
    const int gw = F.vcu * NWAVES + F.wave, NGW = F.G * NWAVES;
    for (int m = gw; m < M; m += NGW) {
        GAS f32x4* xr = (GAS f32x4*)(X + (size_t)m * D) + F.lane; f32x4 v[4]; float s = 0.f;
#pragma unroll
        for (int j = 0; j < 4; ++j) { v[j] = xr[64 * j]; s += (v[j].x * v[j].x + v[j].y * v[j].y) + (v[j].z * v[j].z + v[j].w * v[j].w); }
        const float rstd = 1.0f / sqrtf(wave_sum(s) * (1.0f / D) + EPS);
#pragma unroll
        for (int j = 0; j < 4; ++j) { const f32x4 gv = *(const f32x4*)(g + 4 * F.lane + 256 * j); xr[64 * j] = v[j] * rstd * gv; }
    }
}

__device__ __forceinline__ void spatial_phase(Frame& F, const Args& a) {
    frame_refresh(F);
    unsigned char* ws = a.ws;
    const bf16* U = (const bf16*)(ws + WS_U); const bf16* V = (const bf16*)(ws + WS_V); bf16* Gm = (bf16*)(ws + WS_G);
    const float* vstat = (const float*)(ws + WS_VSTAT);
    const float* lng = a.in[12]; const float* lnb = a.in[13]; const float* bsp = a.in[15];
    LAS unsigned short* vt = (LAS unsigned short*)(F.lds + RING_OFF);
    const int r = F.lane & 31, h = F.lane >> 5;
    for (int unit = F.vcu; unit < 136 * 4; unit += F.G) {
        const int ch = unit >> 2, g = unit & 3; const bool prompt = ch < 128;
        const int row0 = prompt ? ch * 128 : NP + (ch - 128) * 128;
        const bool is_last = prompt ? ((ch & 15) == 15) : true;
        const bf16* Am = (const bf16*)(ws + WS_WSP) + (prompt ? 0 : 65536) + g * 16384;
        {
            const int c8 = (F.tid & 31) * 8, cg = 256 * g + c8;
            float lg[8], lb[8];
#pragma unroll
            for (int i = 0; i < 8; ++i) { lg[i] = lng[cg + i]; lb[i] = lnb[cg + i]; }
            for (int pass = 0; pass < 8; ++pass) {
                const int rr = pass * 16 + (F.tid >> 5), grow = row0 + rr;
                const v4u raw = *(const v4u*)(V + (size_t)grow * D + cg);
                const float mean = vstat[2 * (size_t)grow] * (1.0f / 1024.0f); float var = vstat[2 * (size_t)grow + 1] * (1.0f / 1024.0f) - mean * mean; var = var < 0.f ? 0.f : var;
                const float rstd = 1.0f / sqrtf(var + EPS);
                float vn[8];
#pragma unroll
                for (int i = 0; i < 4; ++i) { const unsigned wv = raw[i]; vn[2 * i] = (bf2f((unsigned short)(wv & 0xffffu)) - mean) * rstd * lg[2 * i] + lb[2 * i]; vn[2 * i + 1] = (bf2f((unsigned short)(wv >> 16)) - mean) * rstd * lg[2 * i + 1] + lb[2 * i + 1]; }
                if (is_last) {
                    float* op = prompt ? a.out + OUT_VP + ((size_t)(ch >> 4) * 128 + rr) * D + cg : a.out + OUT_VS + (size_t)(grow - NP) * D + cg;
                    *(f32x4*)op = (f32x4){vn[0], vn[1], vn[2], vn[3]}; *(f32x4*)(op + 4) = (f32x4){vn[4], vn[5], vn[6], vn[7]};
                }
                v4u w; w.x = pk2(vn[0], vn[1]); w.y = pk2(vn[2], vn[3]); w.z = pk2(vn[4], vn[5]); w.w = pk2(vn[6], vn[7]);
                *(LAS v4u*)(vt + rr * 256 + c8) = w;
            }
        }
        __syncthreads();
        const int n0 = 32 * F.wave;
        f32x16 acc[4];
#pragma unroll
        for (int mt = 0; mt < 4; ++mt)
#pragma unroll
            for (int i = 0; i < 16; ++i) acc[mt][i] = 0.f;
#pragma unroll
        for (int ks = 0; ks < 8; ++ks) {
            const int k0 = 16 * ks;
            bf16x8 bfr;
#pragma unroll
            for (int j = 0; j < 8; ++j) bfr[j] = (short)vt[(k0 + 8 * h + j) * 256 + n0 + r];
#pragma unroll
            for (int mt = 0; mt < 4; ++mt) {
                if (prompt && k0 >= 32 * (mt + 1)) continue;
                const bf16x8 afr = *(const bf16x8*)(Am + (size_t)(32 * mt + r) * 128 + k0 + 8 * h);
                acc[mt] = __builtin_amdgcn_mfma_f32_32x32x16_bf16(afr, bfr, acc[mt], 0, 0, 0);
            }
        }
        __syncthreads();
        {
            LAS float* mx = (LAS float*)(F.lds + RING_OFF);
#pragma unroll
            for (int mt = 0; mt < 4; ++mt)
#pragma unroll
                for (int i = 0; i < 16; ++i) {
                    const int t = 32 * mt + (i & 3) + 8 * (i >> 2) + 4 * h;
                    mx[t * 256 + n0 + r] = acc[mt][i] + bsp[g * 128 + (prompt ? t : (t & 7))];
                }
        }
        __syncthreads();
        {
            const LAS float* mx = (const LAS float*)(F.lds + RING_OFF);
            const int c8 = (F.tid & 31) * 8, cg = 256 * g + c8;
            for (int pass = 0; pass < 8; ++pass) {
                const int rr = pass * 16 + (F.tid >> 5), grow = row0 + rr;
                const v4u uraw = *(const v4u*)(U + (size_t)grow * D + cg);
                const f32x4 m0 = *(const LAS f32x4*)(mx + rr * 256 + c8), m1 = *(const LAS f32x4*)(mx + rr * 256 + c8 + 4);
                v4u w;
                w.x = pk2(bf2f((unsigned short)(uraw.x & 0xffffu)) * m0[0], bf2f((unsigned short)(uraw.x >> 16)) * m0[1]);
                w.y = pk2(bf2f((unsigned short)(uraw.y & 0xffffu)) * m0[2], bf2f((unsigned short)(uraw.y >> 16)) * m0[3]);
                w.z = pk2(bf2f((unsigned short)(uraw.z & 0xffffu)) * m1[0], bf2f((unsigned short)(uraw.z >> 16)) * m1[1]);
                w.w = pk2(bf2f((unsigned short)(uraw.w & 0xffffu)) * m1[2], bf2f((unsigned short)(uraw.w >> 16)) * m1[3]);
                *(v4u*)(Gm + (size_t)grow * D + cg) = w;
            }
        }
        __syncthreads();
    }
}

__global__ void __launch_bounds__(NWAVES * 64, 2) mk_fwd(Args args) {
    extern __shared__ __attribute__((aligned(16))) unsigned char lds[];
    Frame F;
    F.lds = (LAS unsigned char*)lds;
    F.MISC = (volatile LAS unsigned*)(F.lds + MISC_OFF);
    F.tid = threadIdx.x; F.lane = F.tid & 63; F.wave = __builtin_amdgcn_readfirstlane(F.tid >> 6);
    F.G = gridDim.x; { const int bx = blockIdx.x; F.vcu = (F.G % 8 == 0) ? (bx % 8) * (F.G / 8) + bx / 8 : bx; }
    unsigned char* ws = args.ws;
    F.ctl = (gu32*)(ws + WS_CTL);
    for (int u = F.tid; u < (LDS_BYTES - LDSCTL_OFF) / 4; u += NWAVES * 64) ((LAS unsigned*)(F.lds + LDSCTL_OFF))[u] = 0u;
    __syncthreads();
    XcdBarrier bar; bar.bar = (unsigned*)(F.ctl + CW_BAR); bar.x = 0; bar.st = nullptr;
    if (N_LAUNCHES == 1) bar = xcd_barrier_post((unsigned*)(F.ctl + CW_BAR), F.MISC + 8);
#define GRID_BAR() do { if (N_LAUNCHES == 1) xcd_barrier(bar); } while (0)
    const int lo = args.ph_lo, hi = args.ph_hi;
    float* X = args.out + OUT_Y;
    const float* MOD = (const float*)(ws + WS_MOD);
    bf16* Hb = (bf16*)(ws + WS_H); bf16* A2 = (bf16*)(ws + WS_A2);
    const int bx = (int)blockIdx.x;

    for (int ph = lo; ph < hi; ++ph) {
        if (ph == 0) p0_prologue(F, args);
        else if (ph == 2) pool_prepass(F, args);
        else if (ph == 9) spatial_phase(F, args);
        else if (ph == 14) final_norm(F, X, args.in[19]);
        else if (ph == 4 || ph == 7 || ph == 11) {
            const int l = ph >= 7, sub = ph != 7;
            norm_rows(F, X, args.in[5] + (2 * l + sub) * 1024, MOD + l * 6144 + (sub ? 3 : 0) * 1024, MOD + l * 6144 + (sub ? 4 : 1) * 1024, Hb);
        } else {
            pg8::Gemm g; EpiAll E; int Mr = M, Nc = D;
            E.F0 = X; E.P0 = MOD; E.P1 = nullptr; E.P2 = nullptr; E.P3 = nullptr; E.B0 = A2; E.B1 = nullptr;
            if (ph == 1) { g = pg8::Gemm{(const bf16*)(ws + WS_SC), (const bf16*)(ws + WS_WADA), 1024, 1024, 1024, 0}; Mr = 256; Nc = MODW; E.mode = 0; E.perm = false; E.F0 = (float*)(ws + WS_MOD); E.P0 = args.in[7]; }
            else if (ph == 3) { g = pg8::Gemm{Hb, (const bf16*)(ws + WS_WP), 256, 1024, 256, 256}; E.mode = 1; E.perm = false; E.P0 = MOD + 2 * 1024; E.P1 = args.in[9]; E.P2 = args.in[0]; E.P3 = args.in[1]; }
            else if (ph == 8) { g = pg8::Gemm{Hb, (const bf16*)(ws + WS_WIN), 1024, 1024, 1024, 0}; Nc = 2048; E.mode = 4; E.perm = true; E.F0 = (float*)(ws + WS_VSTAT); E.P0 = args.in[11]; E.B0 = (bf16*)(ws + WS_U); E.B1 = (bf16*)(ws + WS_V); }
            else if (ph == 10) { g = pg8::Gemm{(const bf16*)(ws + WS_G), (const bf16*)(ws + WS_WOUT), 1024, 1024, 1024, 0}; E.mode = 2; E.perm = false; E.P0 = MOD + 6144 + 2 * 1024; }
            else if (ph == 5 || ph == 12) { const int l = ph == 12; g = pg8::Gemm{Hb, (const bf16*)(ws + WS_W1) + (size_t)l * FF * D, 1024, 1024, 1024, 0}; Nc = FF; E.mode = 3; E.perm = true; }
            else { const int l = ph == 13; g = pg8::Gemm{A2, (const bf16*)(ws + WS_W2) + (size_t)l * FF * D, 4096, 4096, 4096, 0}; E.mode = 2; E.perm = false; E.P0 = MOD + l * 6144 + 5 * 1024; }
            pg8::StaticOrder S; S.init(Mr, Nc, F.G, bx);
            pg8::gemm_phase<EpiAll, pg8::StaticOrder, true, true>(F.lds + RING_OFF, g, S, E);
        }
        if (ph + 1 < hi) GRID_BAR();
    }
}

extern "C" void kernel_launch(void* const* d_in, const int* in_sizes, int n_in, void* d_out, int out_size, void* d_ws, size_t ws_size, hipStream_t stream) {
    static int grid = 0;
    if (grid == 0) {
        if (n_in != 20 || out_size != (int)OUT_END || ws_size < WS_END) { fprintf(stderr, "kernel_launch: unexpected shapes: n_in %d out %d ws %zu\n", n_in, out_size, ws_size); grid = -1; return; }
        int dev = 0, cus = 0, per_cu = 0;
        if (hipGetDevice(&dev) != hipSuccess || hipDeviceGetAttribute(&cus, hipDeviceAttributeMultiprocessorCount, dev) != hipSuccess) { grid = -1; return; }
        if (hipFuncSetAttribute((const void*)mk_fwd, hipFuncAttributeMaxDynamicSharedMemorySize, LDS_BYTES) != hipSuccess) { fprintf(stderr, "kernel_launch: hipFuncSetAttribute failed\n"); grid = -1; return; }
        if (hipOccupancyMaxActiveBlocksPerMultiprocessor(&per_cu, (const void*)mk_fwd, NWAVES * 64, LDS_BYTES) != hipSuccess || per_cu < 1) { fprintf(stderr, "kernel_launch: occupancy query says %d\n", per_cu); per_cu = 1; }
        (void)hipGetLastError();
        grid = cus;
    }
    if (grid < 0) return;
    (void)hipMemsetAsync((char*)d_ws + WS_CTL, 0, CTL_ZERO_BYTES, stream);
    Args a{};
    for (int i = 0; i < 20; ++i) a.in[i] = (const float*)d_in[i];
    a.out = (float*)d_out; a.ws = (unsigned char*)d_ws;
    if (N_LAUNCHES == 1) { a.ph_lo = 0; a.ph_hi = PER_PHASE; hipLaunchKernelGGL(mk_fwd, dim3(grid), dim3(NWAVES * 64), LDS_BYTES, stream, a); }
    else { for (int p = 0; p < PER_PHASE; ++p) { a.ph_lo = p; a.ph_hi = p + 1; hipLaunchKernelGGL(mk_fwd, dim3(grid), dim3(NWAVES * 64), LDS_BYTES, stream, a); } }
}
```
